# Optimizing an MI355X kernel written in HIP

```python
import math
import numpy as np
import jax, jax.numpy as jnp
from jax import lax


D_MODEL = 2048
BATCH = 8
SEQ = 4096
DEPTH = 4

RWKV_HEAD_DIM = 64
RWKV_WIDTH = D_MODEL // 2
RWKV_HEADS = RWKV_WIDTH // RWKV_HEAD_DIM
DIFF_QK_DIM = 64
DIFF_V_DIM = 2 * DIFF_QK_DIM
DIFF_WIDTH = D_MODEL - RWKV_WIDTH
DIFF_HEADS = DIFF_WIDTH // DIFF_V_DIM
DECAY_LORA = 64
AAA_LORA = 64
MV_LORA = 32
GATE_LORA = 160
RWKV_COLS = 3 * RWKV_WIDTH + DECAY_LORA + AAA_LORA + GATE_LORA
DIFF_COLS = 2 * DIFF_HEADS * 2 * DIFF_QK_DIM + DIFF_WIDTH
IN_COLS = RWKV_COLS + DIFF_COLS
D_FF = 5632
CONV_WIDTH = 3
ROPE_THETA = 500000.0
ROPE_DIM = DIFF_QK_DIM // 4
Q_BLOCK = 128
NORM_EPS = 1e-6
GN_EPS = 64e-5
SUBLN_EPS = 1e-5

kernel_name = 'hybrid_rwkv7_diffattn_sandwich'


def rms_norm(x, g, eps=NORM_EPS):
    xf = x.astype(jnp.float32)
    y = xf * lax.rsqrt(jnp.mean(xf * xf, axis=-1, keepdims=True) + eps)
    return (y * g.astype(jnp.float32)).astype(x.dtype)


def token_shift(p, mu):
    prev = jnp.pad(p, ((0, 0), (1, 0), (0, 0)))[:, :-1]
    return p + mu * (prev - p)


def rwkv7_scan(r, decay, k, v, kk, a):
    B, S, H, N = r.shape

    def step(state, inp):
        r_t, w_t, k_t, v_t, kk_t, a_t = inp
        sa = jnp.einsum('bhij,bhj->bhi', state, -kk_t)
        state = (state * w_t[:, :, None, :]
                 + sa[..., None] * (kk_t * a_t)[:, :, None, :]
                 + v_t[..., None] * k_t[:, :, None, :])
        o_t = jnp.einsum('bhij,bhj->bhi', state, r_t)
        return state, o_t

    xs = tuple(jnp.moveaxis(t, 1, 0) for t in (r, decay, k, v, kk, a))
    state0 = jnp.zeros((B, H, N, N), jnp.float32)
    _, out = lax.scan(step, state0, xs)
    return jnp.moveaxis(out, 0, 1)


def rwkv7_group(p_main, p_mv, mu_main, mu_mv, w0, w2, a0, a2, g2, k_k, k_a, r_k,
                gn_w, gn_b, v0, v2, v_first):
    B, S, _ = p_main.shape
    f32 = jnp.float32
    p_main = token_shift(p_main.astype(f32), mu_main)
    sizes = (RWKV_WIDTH, DECAY_LORA, RWKV_WIDTH, RWKV_WIDTH, AAA_LORA, GATE_LORA)
    r, wl, k, v, al, gl = jnp.split(p_main, np.cumsum(sizes)[:-1].tolist(), axis=-1)
    w_log = -jax.nn.softplus(-(w0 + jnp.tanh(wl) @ w2)) - 0.5
    decay = jnp.exp(-jnp.exp(w_log.astype(f32)))
    a = jax.nn.sigmoid(a0 + al @ a2)
    g = jax.nn.sigmoid(gl) @ g2
    if v_first is None:
        v_first = v
    else:
        vl = token_shift(p_mv.astype(f32), mu_mv)
        v = v + (v_first - v) * jax.nn.sigmoid(v0 + vl @ v2)
    heads = lambda t: t.reshape(B, S, RWKV_HEADS, RWKV_HEAD_DIM).astype(f32)
    kk = heads(k * k_k)
    kk = kk / jnp.maximum(jnp.sqrt(jnp.sum(kk * kk, axis=-1, keepdims=True)), 1e-12)
    k = k * (1.0 + (a - 1.0) * k_a)
    r_h, k_h, v_h = heads(r), heads(k), heads(v)
    o = rwkv7_scan(r_h, heads(decay), k_h, v_h, kk, heads(a))
    mean = jnp.mean(o, axis=-1, keepdims=True)
    var = jnp.mean(jnp.square(o - mean), axis=-1, keepdims=True)
    o = ((o - mean) * lax.rsqrt(var + GN_EPS)).reshape(B, S, RWKV_WIDTH) * gn_w + gn_b
    bonus = jnp.sum(r_h * k_h * r_k, axis=-1, keepdims=True) * v_h
    o = (o + bonus.reshape(B, S, RWKV_WIDTH)) * g
    return o, v_first


def rotary_partial(t, cos, sin):
    half = ROPE_DIM // 2
    c = cos[:, :, None, None, :]
    s = sin[:, :, None, None, :]
    t1 = t[..., :half]
    t2 = t[..., half:ROPE_DIM]
    return jnp.concatenate([t1 * c - t2 * s, t2 * c + t1 * s, t[..., ROPE_DIM:]], axis=-1)


def diff_attention_group(q, k, v, cos, sin, lam_q1, lam_k1, lam_q2, lam_k2, subln_w, lambda_init):
    B, S, _ = q.shape
    f32 = jnp.float32
    q = rotary_partial(q.reshape(B, S, DIFF_HEADS, 2, DIFF_QK_DIM).astype(f32), cos, sin)
    k = rotary_partial(k.reshape(B, S, DIFF_HEADS, 2, DIFF_QK_DIM).astype(f32), cos, sin)
    v = jnp.transpose(v.reshape(B, S, DIFF_HEADS, DIFF_V_DIM).astype(f32), (0, 2, 1, 3))
    lam = (jnp.exp(jnp.sum(lam_q1.astype(f32) * lam_k1.astype(f32)))
           - jnp.exp(jnp.sum(lam_q2.astype(f32) * lam_k2.astype(f32))) + lambda_init)
    q = jnp.transpose(q, (0, 2, 3, 1, 4)) * (DIFF_QK_DIM ** -0.5)
    k = jnp.transpose(k, (0, 2, 3, 1, 4))
    key_pos = jnp.arange(S)

    def block(i):
        start = i * Q_BLOCK
        qb = lax.dynamic_slice_in_dim(q, start, Q_BLOCK, axis=3)
        s = jnp.einsum('bhmqd,bhmkd->bhmqk', qb, k)
        q_pos = start + jnp.arange(Q_BLOCK)
        mask = key_pos[None, :] <= q_pos[:, None]
        p = jax.nn.softmax(jnp.where(mask, s, -jnp.inf), axis=-1)
        attn = p[:, :, 0] - lam * p[:, :, 1]
        return jnp.einsum('bhqk,bhkd->bhqd', attn, v)

    o = lax.map(block, jnp.arange(S // Q_BLOCK))
    o = jnp.transpose(o, (1, 0, 3, 2, 4)).reshape(B, S, DIFF_HEADS, DIFF_V_DIM)
    o = o * lax.rsqrt(jnp.mean(o * o, axis=-1, keepdims=True) + SUBLN_EPS) * subln_w
    o = o * (1.0 - lambda_init)
    return o.reshape(B, S, DIFF_WIDTH)


def conv_glu_ffn(h, w_up, conv_w, conv_b, w_down):
    S = h.shape[1]
    gate, up = jnp.split(h @ w_up, 2, axis=-1)
    gp = jnp.pad(gate, ((0, 0), (CONV_WIDTH - 1, 0), (0, 0)))
    gate = sum(gp[:, j:j + S] * conv_w[j] for j in range(CONV_WIDTH)) + conv_b
    return (jax.nn.gelu(gate, approximate=True) * up) @ w_down


def setup_inputs(seed: int = 0) -> dict:
    key = jax.random.key(seed)
    keys = jax.random.split(key, 40)
    counter = [0]

    def nxt():
        counter[0] += 1
        return keys[counter[0] - 1]

    f32 = jnp.float32
    nrm = lambda shape, scale: jax.random.normal(nxt(), shape, f32) * scale
    unif = lambda shape, lo, hi: jax.random.uniform(nxt(), shape, f32, lo, hi)
    L, Lv = DEPTH, DEPTH - 1
    x = nrm((BATCH, SEQ, D_MODEL), 1.0)
    positions = (jax.random.randint(nxt(), (BATCH, 1), 0, 4096, jnp.int32)
                 + jnp.arange(SEQ, dtype=jnp.int32)[None, :])
    gain = lambda: 1.0 + nrm((L, D_MODEL), 0.05)
    conv_center = jnp.zeros((CONV_WIDTH,), f32).at[-1].set(1.0)
    return {
        'x': x,
        'positions': positions,
        'pre_mix_norm': gain(),
        'post_mix_norm': gain(),
        'pre_ffn_norm': gain(),
        'post_ffn_norm': gain(),
        'w_in': nrm((L, D_MODEL, IN_COLS), D_MODEL ** -0.5),
        'w_mv_down': nrm((Lv, D_MODEL, MV_LORA), D_MODEL ** -0.5),
        'shift_mu': unif((L, RWKV_COLS), 0.0, 1.0),
        'shift_mu_mv': unif((Lv, MV_LORA), 0.0, 1.0),
        'w0': unif((L, RWKV_WIDTH), -6.0, 1.0),
        'w2': nrm((L, DECAY_LORA, RWKV_WIDTH), 0.5 * DECAY_LORA ** -0.5),
        'a0': nrm((L, RWKV_WIDTH), 0.1),
        'a2': nrm((L, AAA_LORA, RWKV_WIDTH), AAA_LORA ** -0.5),
        'g2': nrm((L, GATE_LORA, RWKV_WIDTH), GATE_LORA ** -0.5),
        'k_k': 0.85 + nrm((L, RWKV_WIDTH), 0.05),
        'k_a': 1.0 + nrm((L, RWKV_WIDTH), 0.05),
        'r_k': nrm((L, RWKV_HEADS, RWKV_HEAD_DIM), 0.1),
        'gn_w': 1.0 + nrm((L, RWKV_WIDTH), 0.05),
        'gn_b': nrm((L, RWKV_WIDTH), 0.02),
        'v0': 1.0 + nrm((Lv, RWKV_WIDTH), 0.1),
        'v2': nrm((Lv, MV_LORA, RWKV_WIDTH), MV_LORA ** -0.5),
        'lam_q1': nrm((L, DIFF_QK_DIM), 0.1),
        'lam_k1': nrm((L, DIFF_QK_DIM), 0.1),
        'lam_q2': nrm((L, DIFF_QK_DIM), 0.1),
        'lam_k2': nrm((L, DIFF_QK_DIM), 0.1),
        'subln_w': 1.0 + nrm((L, DIFF_V_DIM), 0.05),
        'w_out': nrm((L, D_MODEL, D_MODEL), D_MODEL ** -0.5),
        'w_up': nrm((L, D_MODEL, 2 * D_FF), D_MODEL ** -0.5),
        'conv_w': nrm((L, CONV_WIDTH, D_FF), 0.2) + conv_center[None, :, None],
        'conv_b': nrm((L, D_FF), 0.02),
        'w_down': nrm((L, D_FF, D_MODEL), D_FF ** -0.5),
    }


def reference(x, positions, pre_mix_norm, post_mix_norm, pre_ffn_norm, post_ffn_norm,
              w_in, w_mv_down, shift_mu, shift_mu_mv, w0, w2, a0, a2, g2, k_k, k_a, r_k,
              gn_w, gn_b, v0, v2, lam_q1, lam_k1, lam_q2, lam_k2, subln_w, w_out,
              w_up, conv_w, conv_b, w_down):
    f32 = jnp.float32
    inv_freq = ROPE_THETA ** (-jnp.arange(0, ROPE_DIM, 2, dtype=f32) / ROPE_DIM)
    ang = positions.astype(f32)[..., None] * inv_freq
    cos, sin = jnp.cos(ang), jnp.sin(ang)
    v_first = None
    for l in range(DEPTH):
        h = rms_norm(x, pre_mix_norm[l])
        if l == 0:
            p = h @ w_in[0]
            p_mv, mu_mv, v0_l, v2_l = None, None, None, None
        else:
            p = h @ jnp.concatenate([w_in[l], w_mv_down[l - 1]], axis=-1)
            p_mv, mu_mv, v0_l, v2_l = p[..., IN_COLS:], shift_mu_mv[l - 1], v0[l - 1], v2[l - 1]
        p_rwkv = p[..., :RWKV_COLS]
        q_d, k_d, v_d = jnp.split(p[..., RWKV_COLS:IN_COLS],
                                  [DIFF_HEADS * 2 * DIFF_QK_DIM, 2 * DIFF_HEADS * 2 * DIFF_QK_DIM], axis=-1)
        o_rwkv, v_first = rwkv7_group(p_rwkv, p_mv, shift_mu[l], mu_mv, w0[l], w2[l], a0[l], a2[l],
                                      g2[l], k_k[l], k_a[l], r_k[l], gn_w[l], gn_b[l], v0_l, v2_l, v_first)
        lambda_init = 0.8 - 0.6 * math.exp(-0.3 * l)
        o_diff = diff_attention_group(q_d, k_d, v_d, cos, sin, lam_q1[l], lam_k1[l], lam_q2[l],
                                      lam_k2[l], subln_w[l], lambda_init)
        mix = jnp.concatenate([o_rwkv, o_diff], axis=-1).astype(x.dtype) @ w_out[l]
        x = x + rms_norm(mix, post_mix_norm[l])
        h = rms_norm(x, pre_ffn_norm[l])
        ff = conv_glu_ffn(h, w_up[l], conv_w[l], conv_b[l], w_down[l])
        x = x + rms_norm(ff, post_ffn_norm[l])
    return x
```

```cpp
#include <hip/hip_runtime.h>
#include <cstdio>
#include <cstdint>
#include <cmath>
namespace pg8 {
#define PG8_LAS __attribute__((address_space(3)))
typedef unsigned short bf16_t;
typedef short bf16x8 __attribute__((ext_vector_type(8)));
typedef float f32x4 __attribute__((ext_vector_type(4)));
typedef unsigned u32x4 __attribute__((ext_vector_type(4)));
constexpr int BM = 256, BK = 64, HALF = 128, HTB = HALF * BK * 2  , STAGE_BYTES = 8 * HTB, NXCD = 8, WGM = 4;

__host__ __device__ __forceinline__ int lds_byte(int r, int c) { const int st = (r >> 4) * 2 + (c >> 5), rr = r & 15, cc = c & 31, ob = rr * 64 + cc * 2; return st * 1024 + (ob ^ (((ob >> 9) & 1) << 5)); }
__host__ __device__ __forceinline__ void stage_rc(int b, int& R, int& C) { const int st = b / 1024, sb = b % 1024, swz = sb ^ (((sb >> 9) & 1) << 5); R = (st >> 1) * 16 + swz / 64; C = (st & 1) * 32 + (swz % 64) / 2; }
__host__ __device__ __forceinline__ int perm32(int rho) { const int n = rho >> 4, i = rho & 15; return 8 * (i >> 2) + 4 * n + (i & 3); }

struct Unit { int pm, pn; };
struct Gemm { const bf16_t* A; const bf16_t* Bt; int M, N, K; };

struct StaticOrder {
    int nM, nN, nwg, G, c, wgm, rot, kmode;
    int pad_;
    __host__ __device__ void init(int M, int N, int G_, int c_, int wgm_ = WGM, int rot_ = 0, int kmode_ = 0) { nM = M / BM; nN = N / BM; nwg = nM * nN; G = G_; c = c_; wgm = wgm_; rot = rot_; kmode = kmode_; pad_ = 0; }
    __host__ __device__ bool next(int i, Unit& u) const {
        const long L = (long)i * G + c; if (L >= nwg) return false;
        int wgid = (int)L; { const int q = nwg / NXCD, r = nwg % NXCD, xcd = wgid % NXCD, off = wgid / NXCD; wgid = (xcd < r ? xcd * (q + 1) : r * (q + 1) + (xcd - r) * q) + off; }
        const int nig = wgm * nN, gid = wgid / nig, fm = gid * wgm, gsz = (nM - fm) < wgm ? (nM - fm) : wgm;
        u.pm = fm + ((wgid % nig) % gsz); u.pn = (wgid % nig) / gsz; if (rot) u.pn = (u.pn + rot * i) % nN; return true;
    }
    __device__ __forceinline__ void a_ready(const Unit&) const {}
    __device__ __forceinline__ void done(const Unit&) const {}
    __device__ __forceinline__ void krange(const Unit& u, int nt_full, int& k0, int& ntu) const {
        if (kmode == 1) { const int blk = u.pn >> 2; k0 = (blk == 2) ? 2 : (blk == 3) ? 4 : 0; ntu = (blk == 2) ? 4 : 2; } else { k0 = 0; ntu = nt_full; } }
};

__device__ __forceinline__ unsigned cvt_pk_bf16(float lo, float hi) { unsigned r; asm volatile("v_cvt_pk_bf16_f32 %0, %1, %2" : "=v"(r) : "v"(lo), "v"(hi)); return r; }
typedef float f32x2 __attribute__((ext_vector_type(2)));
__device__ __forceinline__ f32x2 gelu_pk(f32x2 v) {
    const f32x2 av = __builtin_elementwise_abs(v), d = av * 0.2316418882f + 1.0f;
    f32x2 t; t.x = __builtin_amdgcn_rcpf(d.x); t.y = __builtin_amdgcn_rcpf(d.y);
    f32x2 q = t * 0.5307027145f + (-0.7265760135f); q = q * t + 0.7107068705f; q = q * t + (-0.142248368f); q = q * t + 0.127414796f; q = q * t;
    const f32x2 s = (v * v) * (-0.72134752044f);
    f32x2 e; e.x = __builtin_amdgcn_exp2f(s.x); e.y = __builtin_amdgcn_exp2f(s.y);
    const f32x2 m = v * (q * e), r = v - m;
    f32x2 o; o.x = v.x < 0.f ? m.x : r.x; o.y = v.y < 0.f ? m.y : r.y; return o;
}

template <int ACT  , bool NT = false  > struct EpiBf16 {
    static constexpr bool PERM = true, AFTER_DRAIN = false; static_assert(ACT == 0 || ACT == 1, "EpiBf16: ACT is 0 (none) or 1 (gelu_pk)");
    bf16_t* O; int ldc; const float* bias; int split_cols; size_t split_stride; float scale0;
    __device__ __forceinline__ void operator()(const f32x4 (&acc)[2][2][4][2], const Unit& u, int wr, int wc, int fr, int fq) const {
        const int row0 = u.pm * BM + wr * 64 + fr; int colt = u.pn * BM; bf16_t* base = O;
        float sc = 1.f; if (split_cols) { const int t = colt / split_cols; base += (size_t)t * split_stride; colt -= t * split_cols; if (t == 0) sc = scale0; }
        const int col0 = colt + wc * 32 + 8 * fq, bcol0 = u.pn * BM + wc * 32 + 8 * fq;
        f32x4 bv[2][2];
#pragma unroll
        for (int bj = 0; bj < 2; ++bj)
#pragma unroll
            for (int n = 0; n < 2; ++n) bv[bj][n] = bias ? *(const f32x4*)(bias + bcol0 + bj * HALF + 4 * n) : (f32x4){0.f, 0.f, 0.f, 0.f};
#pragma unroll
        for (int ai = 0; ai < 2; ++ai)
#pragma unroll
            for (int m = 0; m < 4; ++m) { bf16_t* rowp = base + (size_t)(row0 + ai * HALF + m * 16) * ldc + col0;
#pragma unroll
                for (int bj = 0; bj < 2; ++bj) { f32x4 v0 = acc[ai][bj][m][0] + bv[bj][0], v1 = acc[ai][bj][m][1] + bv[bj][1];
                    if (ACT == 1) { f32x2 a = gelu_pk((f32x2){v0[0], v0[1]}), b = gelu_pk((f32x2){v0[2], v0[3]}), c = gelu_pk((f32x2){v1[0], v1[1]}), d = gelu_pk((f32x2){v1[2], v1[3]});
                        v0 = (f32x4){a.x, a.y, b.x, b.y}; v1 = (f32x4){c.x, c.y, d.x, d.y}; }
                    v0 = v0 * sc; v1 = v1 * sc; u32x4 w; w.x = cvt_pk_bf16(v0[0], v0[1]); w.y = cvt_pk_bf16(v0[2], v0[3]); w.z = cvt_pk_bf16(v1[0], v1[1]); w.w = cvt_pk_bf16(v1[2], v1[3]);
                    if (NT) __builtin_nontemporal_store(w, (u32x4*)(rowp + bj * HALF)); else *(u32x4*)(rowp + bj * HALF) = w; } }
    }
};
template <class Epi, class Sched, bool ALIGN_EPI = false, bool SP2 = false>
__device__ __forceinline__ void gemm_phase(PG8_LAS unsigned char* lds, const Gemm g, const Sched& S, const Epi& E, int tid_in  ) {
    int tid_ = tid_in; asm volatile("" : "+v"(tid_));
    const int tid = tid_, wid = __builtin_amdgcn_readfirstlane(tid >> 6), lane = tid & 63, wr = wid >> 2, wc = wid & 3, fr = lane & 15, fq = lane >> 4;
    int K_ = g.K; asm volatile("" : "+s"(K_));
    const int K = K_, nt = K / BK;
    unsigned voffA[2], voffB[2];
#pragma unroll
    for (int i = 0; i < 2; ++i) { int R, C; stage_rc(tid * 16 + i * 8192, R, C); const int Rb = Epi::PERM ? ((R & ~31) + perm32(R & 31)) : R;
        voffA[i] = (unsigned)(R * K + C) * 2u; voffB[i] = (unsigned)(Rb * K + C) * 2u; }
    const size_t kstep = (size_t)(BK * 2);
    const size_t hstep = (size_t)HALF * K * 2;
    const size_t tstep = 2 * hstep;
    const unsigned ldsw = (unsigned)wid * 1024u;
    const int aoff = lds_byte(wr * 64 + fr, fq * 8), boff = lds_byte(wc * 32 + fr, fq * 8);
#define PG8_SA(b, h) (((b) * 2 + (h)) * HTB)
#define PG8_SB(b, h) ((4 + (b) * 2 + (h)) * HTB)
#define PG8_STAGE(bufoff, gbase, voff) do { _Pragma("unroll") for (int _i = 0; _i < 2; ++_i) \
        __builtin_amdgcn_global_load_lds((const unsigned*)((const char*)(gbase) + (voff)[_i]), (PG8_LAS unsigned*)(lds + (bufoff) + ldsw + _i * 8192), 16, 0, 0); } while (0)
#define PG8_LDA(dst, b, h) do { _Pragma("unroll") for (int m = 0; m < 4; ++m) _Pragma("unroll") for (int k = 0; k < 2; ++k) dst[m][k] = *(const PG8_LAS bf16x8*)(lds + PG8_SA(b, h) + aoff + m * 2048 + k * 1024); } while (0)
#define PG8_LDB(dst, b, h) do { _Pragma("unroll") for (int n = 0; n < 2; ++n) _Pragma("unroll") for (int k = 0; k < 2; ++k) dst[n][k] = *(const PG8_LAS bf16x8*)(lds + PG8_SB(b, h) + boff + n * 2048 + k * 1024); } while (0)
#define PG8_MMA(ai, bj, At, Bt) do { __builtin_amdgcn_s_setprio(1); _Pragma("unroll") for (int m = 0; m < 4; ++m) _Pragma("unroll") for (int n = 0; n < 2; ++n) _Pragma("unroll") for (int k = 0; k < 2; ++k) \
        acc[ai][bj][m][n] = __builtin_amdgcn_mfma_f32_16x16x32_bf16(Bt[n][k], At[m][k], acc[ai][bj][m][n], 0, 0, 0); __builtin_amdgcn_s_setprio(0); } while (0)
#define PG8_WAIT_V(n) asm volatile("s_waitcnt vmcnt(" #n ")" ::: "memory")
#define PG8_WAIT_L(n) asm volatile("s_waitcnt lgkmcnt(" #n ")" ::: "memory")
#define PG8_BAR __builtin_amdgcn_s_barrier()
#define PG8_SCHED __builtin_amdgcn_sched_barrier(0)
    Unit cur, nxt; int ui = 0;
    if (!S.next(0, cur)) return;
    f32x4 acc[2][2][4][2];
#pragma unroll
    for (int a = 0; a < 2; ++a)
#pragma unroll
        for (int b = 0; b < 2; ++b)
#pragma unroll
            for (int m = 0; m < 4; ++m)
#pragma unroll
                for (int n = 0; n < 2; ++n) acc[a][b][m][n] = (f32x4){0.f, 0.f, 0.f, 0.f};
    bf16x8 At[4][2], B0[2][2], B1[2][2];
    int k0c, ntc; S.krange(cur, nt, k0c, ntc);
    const char* cA = (const char*)g.A + (size_t)cur.pm * tstep + (size_t)k0c * kstep; const char* cB = (const char*)g.Bt + (size_t)cur.pn * tstep + (size_t)k0c * kstep;
    S.a_ready(cur);
    if constexpr (SP2) {
        PG8_STAGE(PG8_SB(0, 0), cB, voffB); PG8_STAGE(PG8_SB(0, 1), cB + hstep, voffB); PG8_STAGE(PG8_SA(0, 0), cA, voffA); PG8_STAGE(PG8_SA(0, 1), cA + hstep, voffA);
        if (wr == 1) PG8_BAR;
        PG8_WAIT_V(2); PG8_BAR;
        PG8_STAGE(PG8_SB(1, 0), cB + kstep, voffB); PG8_STAGE(PG8_SA(1, 0), cA + kstep, voffA); PG8_STAGE(PG8_SB(1, 1), cB + hstep + kstep, voffB);
        PG8_WAIT_V(6); PG8_BAR;
    } else {
        PG8_STAGE(PG8_SB(0, 0), cB, voffB); PG8_STAGE(PG8_SA(0, 0), cA, voffA); PG8_STAGE(PG8_SB(0, 1), cB + hstep, voffB); PG8_STAGE(PG8_SA(0, 1), cA + hstep, voffA);
        if (wr == 1) PG8_BAR;
        PG8_WAIT_V(4); PG8_BAR;
        PG8_STAGE(PG8_SB(1, 0), cB + kstep, voffB); PG8_STAGE(PG8_SA(1, 0), cA + kstep, voffA); PG8_STAGE(PG8_SB(1, 1), cB + hstep + kstep, voffB);
        PG8_WAIT_V(6); PG8_BAR;
    }
    for (;;) {
        const bool has_next = S.next(ui + 1, nxt);
        int k0n = 0, ntn = nt; if (has_next) S.krange(nxt, nt, k0n, ntn);
        const char* nA = has_next ? (const char*)g.A + (size_t)nxt.pm * tstep + (size_t)k0n * kstep : cA; const char* nB = has_next ? (const char*)g.Bt + (size_t)nxt.pn * tstep + (size_t)k0n * kstep : cB;
        for (int t = 0; t < ntc; t += 2) {
            const bool last = (t == ntc - 2);
            const char* a1 = cA + (size_t)(t + 1) * kstep;
            const char* a2 = last ? nA : cA + (size_t)(t + 2) * kstep; const char* b2 = last ? nB : cB + (size_t)(t + 2) * kstep;
            const char* a3 = a2 + kstep; const char* b3 = b2 + kstep;
            if (last && has_next) S.a_ready(nxt);
            if constexpr (SP2) {
            PG8_LDB(B0, 0, 0); PG8_LDB(B1, 0, 1); PG8_SCHED; PG8_LDA(At, 0, 0); PG8_STAGE(PG8_SA(1, 1), a1 + hstep, voffA);
            PG8_WAIT_V(8); PG8_WAIT_L(0); PG8_BAR; PG8_MMA(0, 0, At, B0); PG8_MMA(0, 1, At, B1); PG8_BAR; PG8_SCHED;
            PG8_LDA(At, 0, 1); PG8_STAGE(PG8_SB(0, 0), b2, voffB); PG8_STAGE(PG8_SB(0, 1), b2 + hstep, voffB); PG8_STAGE(PG8_SA(0, 0), a2, voffA);
            PG8_WAIT_V(8); PG8_WAIT_L(0); PG8_BAR; PG8_MMA(1, 0, At, B0); PG8_MMA(1, 1, At, B1); PG8_BAR; PG8_SCHED;
            PG8_LDB(B0, 1, 0); PG8_LDB(B1, 1, 1); PG8_SCHED; PG8_LDA(At, 1, 0); PG8_STAGE(PG8_SA(0, 1), a2 + hstep, voffA);
            PG8_WAIT_V(8); PG8_WAIT_L(0); PG8_BAR; PG8_MMA(0, 0, At, B0); PG8_MMA(0, 1, At, B1); PG8_BAR; PG8_SCHED;
            PG8_LDA(At, 1, 1); PG8_STAGE(PG8_SB(1, 0), b3, voffB); PG8_STAGE(PG8_SB(1, 1), b3 + hstep, voffB); PG8_STAGE(PG8_SA(1, 0), a3, voffA);
            PG8_WAIT_V(8); PG8_WAIT_L(0); PG8_BAR; PG8_MMA(1, 0, At, B0); PG8_MMA(1, 1, At, B1); PG8_BAR; PG8_SCHED;
            } else {
            PG8_LDB(B0, 0, 0); PG8_SCHED; PG8_LDA(At, 0, 0); PG8_STAGE(PG8_SA(1, 1), a1 + hstep, voffA);
            PG8_WAIT_L(8); PG8_BAR; PG8_WAIT_L(0); PG8_MMA(0, 0, At, B0); PG8_BAR; PG8_SCHED;
            PG8_LDB(B1, 0, 1); PG8_STAGE(PG8_SB(0, 0), b2, voffB);
            PG8_BAR; PG8_WAIT_L(0); PG8_MMA(0, 1, At, B1); PG8_BAR;
            PG8_LDA(At, 0, 1); PG8_STAGE(PG8_SA(0, 0), a2, voffA);
            PG8_BAR; PG8_WAIT_L(0); PG8_MMA(1, 0, At, B0); PG8_BAR; PG8_SCHED;
            PG8_STAGE(PG8_SB(0, 1), b2 + hstep, voffB);
            PG8_WAIT_V(6); PG8_BAR; PG8_MMA(1, 1, At, B1); PG8_BAR;
            PG8_LDB(B0, 1, 0); PG8_SCHED; PG8_LDA(At, 1, 0); PG8_STAGE(PG8_SA(0, 1), a2 + hstep, voffA);
            PG8_WAIT_L(8); PG8_BAR; PG8_WAIT_L(0); PG8_MMA(0, 0, At, B0); PG8_BAR; PG8_SCHED;
            PG8_LDB(B1, 1, 1); PG8_STAGE(PG8_SB(1, 0), b3, voffB);
            PG8_BAR; PG8_WAIT_L(0); PG8_MMA(0, 1, At, B1); PG8_BAR;
            PG8_LDA(At, 1, 1); PG8_STAGE(PG8_SA(1, 0), a3, voffA);
            PG8_BAR; PG8_WAIT_L(0); PG8_MMA(1, 0, At, B0); PG8_BAR; PG8_SCHED;
            PG8_STAGE(PG8_SB(1, 1), b3 + hstep, voffB);
            PG8_WAIT_V(6); PG8_BAR; PG8_MMA(1, 1, At, B1); PG8_BAR;
            }
        }
        if constexpr (ALIGN_EPI) { if (wr == 0) PG8_BAR; }
        if constexpr (!Epi::AFTER_DRAIN) { E(acc, cur, wr, wc, fr, fq); S.done(cur); }
        if (!has_next) break;
#pragma unroll
        for (int a = 0; a < 2; ++a)
#pragma unroll
            for (int b = 0; b < 2; ++b)
#pragma unroll
                for (int m = 0; m < 4; ++m)
#pragma unroll
                    for (int n = 0; n < 2; ++n) acc[a][b][m][n] = (f32x4){0.f, 0.f, 0.f, 0.f};
        cur = nxt; cA = nA; cB = nB; ntc = ntn; ++ui;
        if constexpr (ALIGN_EPI) { if (wr == 1) PG8_BAR; }
    }
    PG8_WAIT_V(0);
    if constexpr (!ALIGN_EPI) { if (wr == 0) PG8_BAR; }
    PG8_BAR;
    if constexpr (Epi::AFTER_DRAIN) { E.fused(acc, cur, wr, wc, fr, fq, lds, wid, lane); S.done(cur); }
#undef PG8_SA
#undef PG8_SB
#undef PG8_STAGE
#undef PG8_LDA
#undef PG8_LDB
#undef PG8_MMA
#undef PG8_WAIT_V
#undef PG8_WAIT_L
#undef PG8_BAR
#undef PG8_SCHED
}
}
#define LAS __attribute__((address_space(3)))
#define XB_TMO      128
#define XB_XCNT(j)  (256  + 64 * (j))
#define XB_XSUB(j)  (1280 + 64 * (j))
#define XB_XGEN(j)  (2304 + 64 * (j))
#define XB_TOP      3328
#define XB_TOPGEN   3392
#define XCD_BAR_WORDS 3456
#define XB_SPIN_CAP (1u << 23)

__device__ __forceinline__ unsigned xb_ld(unsigned* p)              { return __hip_atomic_load(p, __ATOMIC_RELAXED, __HIP_MEMORY_SCOPE_AGENT); }
__device__ __forceinline__ unsigned xb_add(unsigned* p, unsigned v) { return __hip_atomic_fetch_add(p, v, __ATOMIC_RELAXED, __HIP_MEMORY_SCOPE_AGENT); }
__device__ __forceinline__ unsigned xb_xcc_id() { return (unsigned)__builtin_amdgcn_s_getreg((3 << 11) | 20) & 0xFu; }
#define XB_SPIN(cond, bar) do { unsigned _sp = 0; while (cond) { __builtin_amdgcn_s_sleep(1); \
    if ((++_sp & 255u) == 0u) { if (xb_ld(&(bar)[XB_TMO])) break; if (_sp > XB_SPIN_CAP) { atomicAdd(&(bar)[XB_TMO], 1u); break; } } } } while (0)

struct XcdBarrier {
    unsigned* bar; unsigned x;
    volatile LAS unsigned* st;
};

__device__ __forceinline__ XcdBarrier xcd_barrier_post(unsigned* bar, volatile LAS unsigned* st) {
    XcdBarrier b; b.bar = bar; b.x = xb_xcc_id(); b.st = st;
    if (threadIdx.x == 0) (void)xb_add(&bar[XB_XCNT(b.x)], 1u);
    return b;
}
__device__ __forceinline__ void xcd_barrier_complete(unsigned* bar, unsigned x, unsigned& nloc, unsigned& nx) {
    const unsigned G = gridDim.x * gridDim.y * gridDim.z;
    unsigned sum, cnt, mine, sp = 0u;
    for (;;) {
        sum = 0u; cnt = 0u; mine = 0u;
#pragma unroll
        for (unsigned j = 0; j < 16; ++j) { const unsigned c = xb_ld(&bar[XB_XCNT(j)]); sum += c; cnt += (c > 0u) ? 1u : 0u; mine = (j == x) ? c : mine; }
        if (sum == G) break;
        __builtin_amdgcn_s_sleep(1);
        if ((++sp & 255u) == 0u) { if (xb_ld(&bar[XB_TMO])) break; if (sp > XB_SPIN_CAP) { atomicAdd(&bar[XB_TMO], 1u); break; } }
    }
    nloc = mine > 0u ? mine : 1u; nx = cnt > 0u ? cnt : 1u;
}

__device__ __forceinline__ void xcd_barrier(const XcdBarrier& b, const int tid_x  ) {
    asm volatile("s_waitcnt vmcnt(0)" ::: "memory");
    __syncthreads();
    if (tid_x == 0) {
        unsigned* bar = b.bar;
        __builtin_amdgcn_s_waitcnt(0);
        unsigned nloc = b.st[0], nx = b.st[1];
        if (nloc == 0u) { xcd_barrier_complete(bar, b.x, nloc, nx); b.st[0] = nloc; b.st[1] = nx; }
        const unsigned old = xb_add(&bar[XB_XSUB(b.x)], 1u);
        const unsigned gen = old / nloc;
        if (old + 1u == (gen + 1u) * nloc) {
            __builtin_amdgcn_fence(__ATOMIC_RELEASE, "agent");
            asm volatile("s_waitcnt vmcnt(0)" ::: "memory");
            const unsigned og = xb_add(&bar[XB_TOP], 1u);
            const unsigned tg = og / nx;
            if (og + 1u == (tg + 1u) * nx) xb_add(&bar[XB_TOPGEN], 1u);
            else XB_SPIN(xb_ld(&bar[XB_TOPGEN]) == tg, bar);
            __builtin_amdgcn_fence(__ATOMIC_ACQUIRE, "agent");
            xb_add(&bar[XB_XGEN(b.x)], 1u);
            asm volatile("s_waitcnt vmcnt(0)" ::: "memory");
        } else {
            XB_SPIN(xb_ld(&bar[XB_XGEN(b.x)]) == gen, bar);
            __builtin_amdgcn_fence(__ATOMIC_ACQUIRE, "agent");
            asm volatile("s_waitcnt vmcnt(0)" ::: "memory");
        }
    }
    __syncthreads();
}

#ifndef MK_SINGLE
#define MK_SINGLE 1
#endif
#define GAS __attribute__((address_space(1)))
typedef unsigned short bf16;
typedef unsigned v4u __attribute__((ext_vector_type(4)));
typedef unsigned v2u __attribute__((ext_vector_type(2)));
typedef float f32x4 __attribute__((ext_vector_type(4)));
typedef float f32x16 __attribute__((ext_vector_type(16)));
typedef short bf16x8 __attribute__((ext_vector_type(8)));
typedef float f32x2_t __attribute__((ext_vector_type(2)));
typedef __bf16 bf16x2_t __attribute__((ext_vector_type(2)));

constexpr int NWAVES = 8;
constexpr int BATCH = 8, SEQ = 4096, DM = 2048, DEPTH = 4, M = BATCH * SEQ;
constexpr int RW = 1024, DFF = 5632, IN_COLS = 6432, PP = 6656  , LAK = 384, LON = 4096;
constexpr int C_R = 0, C_WL = 1024, C_K = 1088, C_V = 2112, C_AL = 3136, C_GL = 3200, C_Q = 3360, C_KD = 4384, C_VD = 5408, C_MV = 6432;
constexpr float QSCALE = 0.125f * 1.4426950408889634f;
constexpr int NPHASE = 11 * DEPTH;

constexpr size_t MiB = 1u << 20;
constexpr size_t WS_CTL = 0, CTL_ZERO_BYTES = 1 * MiB;
constexpr size_t WS_CS = 1 * MiB;
constexpr size_t WS_WIN = 4 * MiB, WS_WL = 30 * MiB, WS_WOUT = 33 * MiB, WS_WUP = 41 * MiB, WS_WDN = 85 * MiB;
constexpr size_t WS_XB = 108 * MiB;
constexpr size_t OUT_H = 0, OUT_VF = 128 * MiB;
constexpr size_t WS_H = WS_XB;
constexpr size_t WS_VF = 236 * MiB;
constexpr size_t WS_R = 300 * MiB;
constexpr size_t WS_P = WS_R, WS_LA = WS_R + 416 * MiB, WS_LO = WS_R + 440 * MiB, WS_MIXIN = WS_R + 696 * MiB, WS_MIX = WS_R;
constexpr size_t WS_UP = WS_R, WS_ACT = WS_R + 704 * MiB, WS_FF = WS_R;
constexpr size_t WS_END = WS_R + 1056 * MiB;
static_assert(WS_WIN + (size_t)PP * DM * 2 <= WS_WL && WS_WL + (size_t)LON * LAK * 2 <= WS_WOUT && WS_WOUT + (size_t)DM * DM * 2 <= WS_WUP && WS_WUP + (size_t)2 * DFF * DM * 2 <= WS_WDN && WS_WDN + (size_t)DM * DFF * 2 <= WS_H, "ws map: weights");
static_assert(WS_H + (size_t)M * DM * 2 <= WS_VF && WS_VF + (size_t)M * RW * 2 <= WS_R, "ws map: H/VF");
static_assert(WS_P + (size_t)M * PP * 2 <= WS_LA && WS_LA + (size_t)M * LAK * 2 <= WS_LO && WS_LO + (size_t)M * LON * 2 <= WS_MIXIN && WS_MIXIN + (size_t)M * DM * 2 <= WS_END, "ws map: mixer");
static_assert(WS_UP + (size_t)M * 2 * DFF * 2 <= WS_ACT && WS_ACT + (size_t)M * DFF * 2 <= WS_END, "ws map: ffn");
constexpr int CW_KMAX = 1024;
constexpr int CW_Q = 2048;
constexpr int CW_BAR = 4096;

constexpr int RING_BYTES = 131072, LDSCTL_OFF = RING_BYTES, MISC_OFF = LDSCTL_OFF + 320, LDS_BYTES = 147456;

#define LDS_WAIT() asm volatile("s_waitcnt lgkmcnt(0)" ::: "memory")

struct Args { const float* in[32]; float* out; unsigned char* ws; int ph_lo, ph_hi, li, pad; };
__device__ __forceinline__ float inv_freq_of(int j) { return j == 0 ? 1.0f : j == 1 ? 0.1939227432012558f : j == 2 ? 0.03760603070259094f : j == 3 ? 0.007292664609849453f : j == 4 ? 0.0014142135623842478f : j == 5 ? 0.00027424818836152554f : j == 6 ? 5.3182957344688475e-05f : 1.0313385246263351e-05f; }
__device__ __forceinline__ float lam_init_of(int l) { return l == 0 ? 0.20000000298023224f : l == 1 ? 0.35550907254219055f : l == 2 ? 0.4707130193710327f : 0.5560582280158997f; }
typedef const Args __attribute__((address_space(4)))* KA;
struct Ctx { LAS unsigned char* lds; int tid, lane, wave, G, vcu, gw, NGW; };

__device__ __forceinline__ float bf_lo(unsigned u) { return __uint_as_float(u << 16); }
__device__ __forceinline__ float bf_hi(unsigned u) { return __uint_as_float(u & 0xffff0000u); }
__device__ __forceinline__ float bf2f(bf16 h) { return __uint_as_float((unsigned)h << 16); }
__device__ __forceinline__ unsigned cvtpk(float lo, float hi) { f32x2_t v = {lo, hi}; bf16x2_t b = __builtin_convertvector(v, bf16x2_t); return __builtin_bit_cast(unsigned, b); }
__device__ __forceinline__ bf16 f2bf(float f) { return (bf16)(cvtpk(f, 0.f) & 0xffffu); }
__device__ __forceinline__ void unpack8(const v4u v, float* f) { f[0] = bf_lo(v.x); f[1] = bf_hi(v.x); f[2] = bf_lo(v.y); f[3] = bf_hi(v.y); f[4] = bf_lo(v.z); f[5] = bf_hi(v.z); f[6] = bf_lo(v.w); f[7] = bf_hi(v.w); }
__device__ __forceinline__ v4u pack8(const float* f) { v4u o; o.x = cvtpk(f[0], f[1]); o.y = cvtpk(f[2], f[3]); o.z = cvtpk(f[4], f[5]); o.w = cvtpk(f[6], f[7]); return o; }
__device__ __forceinline__ float wave_sum(float v) {
#pragma unroll
    for (int o = 1; o < 64; o <<= 1) v += __shfl_xor(v, o);
    return v;
}
#define DPPF(x, ctrl) __int_as_float(__builtin_amdgcn_update_dpp(0, __float_as_int(x), (ctrl), 0xf, 0xf, true))
__device__ __forceinline__ float sigmoidf_(float x) { return __builtin_amdgcn_rcpf(1.f + __expf(-x)); }
__device__ __forceinline__ float tanhf_(float x) { return 1.f - 2.f * __builtin_amdgcn_rcpf(1.f + __expf(2.f * x)); }

__device__ __forceinline__ void transpose_item(const float* __restrict__ W, int K, int N, bf16* WT, int row_off, float scale, LAS float* scr, int item, int lane) {
    const int nblk = N / 32, kb = item / nblk, nb = item % nblk, k0 = 64 * kb, n0 = 32 * nb;
    float wv[32];
#pragma unroll
    for (int i = 0; i < 32; ++i) wv[i] = __builtin_nontemporal_load(W + (size_t)(k0 + 2 * i + (lane >> 5)) * N + n0 + (lane & 31));
#pragma unroll
    for (int i = 0; i < 32; ++i) scr[(2 * i + (lane >> 5)) * 33 + (lane & 31)] = wv[i];
    LDS_WAIT(); asm volatile("" ::: "memory");
    const int c = lane & 7;
#pragma unroll
    for (int j = 0; j < 4; ++j) { const int n = (lane >> 3) + 8 * j; const LAS float* s = scr + (8 * c) * 33 + n;
        v4u o; o.x = cvtpk(s[0 * 33] * scale, s[1 * 33] * scale); o.y = cvtpk(s[2 * 33] * scale, s[3 * 33] * scale); o.z = cvtpk(s[4 * 33] * scale, s[5 * 33] * scale); o.w = cvtpk(s[6 * 33] * scale, s[7 * 33] * scale);
        *(v4u*)(WT + (size_t)(row_off + n0 + n) * K + k0 + 8 * c) = o; }
    LDS_WAIT(); asm volatile("" ::: "memory");
}

__device__ __forceinline__ void ph_wconv(KA A, const Ctx& C, int l) {
    bf16* Win = (bf16*)(A->ws + WS_WIN); bf16* WL = (bf16*)(A->ws + WS_WL); bf16* Wout = (bf16*)(A->ws + WS_WOUT); bf16* Wup = (bf16*)(A->ws + WS_WUP); bf16* Wdn = (bf16*)(A->ws + WS_WDN);
    LAS float* scr = (LAS float*)(C.lds + C.wave * 16384);
    const float* w_in = A->in[6] + (size_t)l * DM * IN_COLS;
    const float* w_mv = A->in[7] + (size_t)(l > 0 ? l - 1 : 0) * DM * 32;
    const float* w_out = A->in[27] + (size_t)l * DM * DM;
    const float* w_up = A->in[28] + (size_t)l * DM * 2 * DFF;
    const float* w_dn = A->in[31] + (size_t)l * DFF * DM;
    constexpr int I_IN = 32 * 201, I_MV = 32, I_OUT = 32 * 64, I_UP = 32 * 352, I_DN = 88 * 64;
    const int i_mv = l > 0 ? I_MV : 0;
    const int NIT = I_IN + i_mv + I_OUT + I_UP + I_DN;
    for (int it = C.gw; it < NIT; it += C.NGW) {
        int r = it;
        if (r < I_IN) { const int n0 = 32 * (r % 201); const float sc = (n0 >= C_Q && n0 < C_KD) ? QSCALE : 1.f; transpose_item(w_in, DM, IN_COLS, Win, 0, sc, scr, r, C.lane); continue; } r -= I_IN;
        if (r < i_mv) { transpose_item(w_mv, DM, 32, Win, IN_COLS, 1.f, scr, r, C.lane); continue; } r -= i_mv;
        if (r < I_OUT) { transpose_item(w_out, DM, DM, Wout, 0, 1.f, scr, r, C.lane); continue; } r -= I_OUT;
        if (r < I_UP) { const int n0 = 32 * (r % 352);
            const int n1 = n0 < DFF ? 256 * (n0 / 128) + (n0 % 128) : 256 * ((n0 - DFF) / 128) + 128 + ((n0 - DFF) % 128);
            transpose_item(w_up, DM, 2 * DFF, Wup, n1 - n0, 1.f, scr, r, C.lane); continue; } r -= I_UP;
        transpose_item(w_dn, DFF, DM, Wdn, 0, 1.f, scr, r, C.lane);
    }
    {
        const int r0 = l > 0 ? IN_COLS + 32 : IN_COLS; const int nch = (PP - r0) * (DM / 8);
        for (int i = C.gw * 64 + C.lane; i < nch; i += C.NGW * 64) *(v4u*)(Win + (size_t)r0 * DM + (size_t)i * 8) = (v4u){0u, 0u, 0u, 0u};
    }
    {
        const float* w2 = A->in[11] + (size_t)l * 64 * RW; const float* a2 = A->in[13] + (size_t)l * 64 * RW; const float* g2 = A->in[14] + (size_t)l * 160 * RW;
        const float* v2 = A->in[21] + (size_t)(l > 0 ? l - 1 : 0) * 32 * RW;
        for (int i = C.gw * 64 + C.lane; i < LON * (LAK / 8); i += C.NGW * 64) {
            const int n = i % LON, k0 = (i / LON) * 8, blk = n >> 10, nn = n & 1023; float val[8];
#pragma unroll
            for (int e = 0; e < 8; ++e) val[e] = 0.f;
            if (blk == 0) { if (k0 < 64) {
#pragma unroll
                for (int e = 0; e < 8; ++e) val[e] = w2[(size_t)(k0 + e) * RW + nn]; } }
            else if (blk == 1) { if (k0 >= 64 && k0 < 128) {
#pragma unroll
                for (int e = 0; e < 8; ++e) val[e] = a2[(size_t)(k0 - 64 + e) * RW + nn]; } }
            else if (blk == 2) { if (k0 >= 128 && k0 < 288) {
#pragma unroll
                for (int e = 0; e < 8; ++e) val[e] = g2[(size_t)(k0 - 128 + e) * RW + nn]; } }
            else { if (l > 0 && k0 >= 288 && k0 < 320) {
#pragma unroll
                for (int e = 0; e < 8; ++e) val[e] = v2[(size_t)(k0 - 288 + e) * RW + nn]; } }
            *(v4u*)(WL + (size_t)n * LAK + k0) = pack8(val);
        }
    }
}

__device__ __forceinline__ void ph_prologue(KA A, const Ctx& C) {
    float* CS = (float*)(A->ws + WS_CS); const int* pos = (const int*)A->in[1];
    for (int i = C.gw * 64 + C.lane; i < M * 8; i += C.NGW * 64) {
        const int m = i >> 3, j = i & 7; const float ang = (float)pos[m] * inv_freq_of(j);
        const double rev = (double)ang * 0.15915494309189535; const float fr = (float)(rev - floor(rev));
        CS[m * 16 + j] = __builtin_amdgcn_cosf(fr); CS[m * 16 + 8 + j] = __builtin_amdgcn_sinf(fr);
    }
    const float* x = A->in[0]; const float* g = A->in[2]; bf16* H = (bf16*)((unsigned char*)A->out + OUT_H);
    for (int m = C.gw; m < M; m += C.NGW) {
        float v[32]; float ss = 0.f;
#pragma unroll
        for (int j = 0; j < 4; ++j) { const int col = (j * 64 + C.lane) * 8; const f32x4 a = *(const f32x4*)(x + (size_t)m * DM + col), b = *(const f32x4*)(x + (size_t)m * DM + col + 4);
            v[8 * j + 0] = a.x; v[8 * j + 1] = a.y; v[8 * j + 2] = a.z; v[8 * j + 3] = a.w; v[8 * j + 4] = b.x; v[8 * j + 5] = b.y; v[8 * j + 6] = b.z; v[8 * j + 7] = b.w;
#pragma unroll
            for (int e = 0; e < 8; ++e) ss += v[8 * j + e] * v[8 * j + e]; }
        const float r = rsqrtf(wave_sum(ss) * (1.f / DM) + 1e-6f);
#pragma unroll
        for (int j = 0; j < 4; ++j) { const int col = (j * 64 + C.lane) * 8; const f32x4 a = *(const f32x4*)(g + col), b = *(const f32x4*)(g + col + 4);
            float o[8]; o[0] = v[8 * j] * r * a.x; o[1] = v[8 * j + 1] * r * a.y; o[2] = v[8 * j + 2] * r * a.z; o[3] = v[8 * j + 3] * r * a.w; o[4] = v[8 * j + 4] * r * b.x; o[5] = v[8 * j + 5] * r * b.y; o[6] = v[8 * j + 6] * r * b.z; o[7] = v[8 * j + 7] * r * b.w;
            *(v4u*)(H + (size_t)m * DM + col) = pack8(o); }
    }
}

__device__ __forceinline__ void ph_res(const Ctx& C, const bf16* Y, const float* xin32, const bf16* xin16, bf16* xout16, float* xout32, const float* gpost, const float* gnext, bf16* H) {
    f32x4 gp[8], gn[8];
#pragma unroll
    for (int j = 0; j < 4; ++j) { const int col = (j * 64 + C.lane) * 8; gp[2 * j] = *(const f32x4*)(gpost + col); gp[2 * j + 1] = *(const f32x4*)(gpost + col + 4);
        if (gnext) { gn[2 * j] = *(const f32x4*)(gnext + col); gn[2 * j + 1] = *(const f32x4*)(gnext + col + 4); } }
    for (int m = C.gw; m < M; m += C.NGW) {
        float y[32]; float ss = 0.f;
#pragma unroll
        for (int j = 0; j < 4; ++j) { const v4u v = __builtin_nontemporal_load((const v4u*)(Y + (size_t)m * DM + (j * 64 + C.lane) * 8)); unpack8(v, y + 8 * j);
#pragma unroll
            for (int e = 0; e < 8; ++e) ss += y[8 * j + e] * y[8 * j + e]; }
        const float r1 = rsqrtf(wave_sum(ss) * (1.f / DM) + 1e-6f);
        float ss2 = 0.f;
#pragma unroll
        for (int j = 0; j < 4; ++j) { const int col = (j * 64 + C.lane) * 8; const size_t off = (size_t)m * DM + col;
            float xv[8];
            if (xin32) { const f32x4 x0 = *(const f32x4*)(xin32 + off), x1 = *(const f32x4*)(xin32 + off + 4); xv[0] = x0.x; xv[1] = x0.y; xv[2] = x0.z; xv[3] = x0.w; xv[4] = x1.x; xv[5] = x1.y; xv[6] = x1.z; xv[7] = x1.w; }
            else unpack8(__builtin_nontemporal_load((const v4u*)(xin16 + off)), xv);
            const f32x4 g0 = gp[2 * j], g1 = gp[2 * j + 1];
            const float gg[8] = {g0.x, g0.y, g0.z, g0.w, g1.x, g1.y, g1.z, g1.w};
#pragma unroll
            for (int e = 0; e < 8; ++e) { y[8 * j + e] = xv[e] + y[8 * j + e] * r1 * gg[e]; }
            if (xout32) { *(f32x4*)(xout32 + off) = (f32x4){y[8 * j], y[8 * j + 1], y[8 * j + 2], y[8 * j + 3]}; *(f32x4*)(xout32 + off + 4) = (f32x4){y[8 * j + 4], y[8 * j + 5], y[8 * j + 6], y[8 * j + 7]}; }
            else { __builtin_nontemporal_store(pack8(y + 8 * j), (v4u*)(xout16 + off)); float t[8]; unpack8(pack8(y + 8 * j), t);
#pragma unroll
                for (int e = 0; e < 8; ++e) y[8 * j + e] = t[e]; }
#pragma unroll
            for (int e = 0; e < 8; ++e) ss2 += y[8 * j + e] * y[8 * j + e]; }
        if (gnext) {
            const float r2 = rsqrtf(wave_sum(ss2) * (1.f / DM) + 1e-6f);
#pragma unroll
            for (int j = 0; j < 4; ++j) { const int col = (j * 64 + C.lane) * 8; const f32x4 g0 = gn[2 * j], g1 = gn[2 * j + 1];
                float o[8]; o[0] = y[8 * j] * r2 * g0.x; o[1] = y[8 * j + 1] * r2 * g0.y; o[2] = y[8 * j + 2] * r2 * g0.z; o[3] = y[8 * j + 3] * r2 * g0.w;
                o[4] = y[8 * j + 4] * r2 * g1.x; o[5] = y[8 * j + 5] * r2 * g1.y; o[6] = y[8 * j + 6] * r2 * g1.z; o[7] = y[8 * j + 7] * r2 * g1.w;
                *(v4u*)(H + (size_t)m * DM + col) = pack8(o); }
        }
    }
}

__device__ __forceinline__ float shiftcol(const bf16* Pm, bool has_prev, int col, float mu) {
    const float p = bf2f(Pm[col]); const float q = has_prev ? bf2f(Pm[col - PP]) : 0.f; return p + mu * (q - p);
}
#ifndef E0_RB
#define E0_RB 4
#endif
__device__ __forceinline__ void ph_e0(KA A, const Ctx& C, int l) {
    bf16* P = (bf16*)(A->ws + WS_P); bf16* LA = (bf16*)(A->ws + WS_LA); const float* CS = (const float*)(A->ws + WS_CS);
    const float* mu = A->in[8] + (size_t)l * 3360; const float* mumv = A->in[9] + (size_t)(l > 0 ? l - 1 : 0) * 32;
    const int lane = C.lane;
    const float mu_wl = mu[C_WL + lane], mu_al = mu[C_AL + lane], mu_g0 = mu[C_GL + lane], mu_g1 = mu[C_GL + 64 + lane];
    const float mu_4 = lane < 32 ? mu[C_GL + 128 + lane] : (l > 0 ? mumv[lane - 32] : 0.f);
    unsigned* kmaxw = (unsigned*)(A->ws + WS_CTL) + CW_KMAX + 128 * l;
    constexpr int RB = E0_RB;
    const int rpw = ((M + C.NGW - 1) / C.NGW + RB - 1) & ~(RB - 1), m_lo = C.gw * rpw, m_hi = (m_lo + rpw < M) ? m_lo + rpw : M;
    float kmx = 0.f; int kb = (m_lo < M) ? (m_lo >> 12) : 0;
    const int c4 = lane < 32 ? C_GL + 128 + lane : C_MV + lane - 32;
    for (int m0 = m_lo; m0 < m_hi; m0 += RB) {
        bf16* P0 = P + (size_t)m0 * PP; bf16* L0 = LA + (size_t)m0 * LAK; const bool hp0 = (m0 & (SEQ - 1)) != 0;
        if ((m0 >> 12) != kb) { if ((lane & 3) == 0) atomicMax(kmaxw + kb * 16 + (lane >> 2), __float_as_uint(kmx)); kmx = 0.f; kb = m0 >> 12; }
        v4u kA[RB], kB[RB]; bf16 nr[5][RB + 1]; v4u rlo[RB / 2], rhi[RB / 2]; f32x4 rc[RB / 2][4];
#pragma unroll
        for (int r = 0; r < RB; ++r) { kA[r] = *(const v4u*)(P0 + r * PP + C_KD + lane * 16); kB[r] = *(const v4u*)(P0 + r * PP + C_KD + lane * 16 + 8); }
        bf16* Prot = P0 + (lane >> 5) * PP + (((lane & 31) < 16) ? C_Q + (lane & 31) * 64 : C_KD + ((lane & 31) - 16) * 64);
#pragma unroll
        for (int rr = 0; rr < RB / 2; ++rr) { rlo[rr] = *(const v4u*)(Prot + rr * 2 * PP); rhi[rr] = *(const v4u*)(Prot + rr * 2 * PP + 8);
            const float* cs = CS + (size_t)(m0 + 2 * rr + (lane >> 5)) * 16;
#pragma unroll
            for (int q = 0; q < 4; ++q) rc[rr][q] = *(const f32x4*)(cs + 4 * q); }
#pragma unroll
        for (int r = 0; r < RB + 1; ++r) { const bool ok = r > 0 || hp0; const bf16* Pr = P0 + (r - 1) * PP;
            nr[0][r] = ok ? Pr[C_WL + lane] : (bf16)0; nr[1][r] = ok ? Pr[C_AL + lane] : (bf16)0; nr[2][r] = ok ? Pr[C_GL + lane] : (bf16)0;
            nr[3][r] = ok ? Pr[C_GL + 64 + lane] : (bf16)0; nr[4][r] = ok ? Pr[c4] : (bf16)0; }
#pragma unroll
        for (int r = 0; r < RB; ++r) {
            bf16* La = L0 + r * LAK; bf16* Pm = P0 + r * PP;
            {   float f[16]; unpack8(kA[r], f); unpack8(kB[r], f + 8);
                float n2 = 0.f;
#pragma unroll
                for (int e = 0; e < 16; ++e) n2 += f[e] * f[e];
                n2 += DPPF(n2, 0xB1); n2 += DPPF(n2, 0x4E); kmx = fmaxf(kmx, n2); }
            float sh[5];
#pragma unroll
            for (int i = 0; i < 5; ++i) { const float p = bf2f(nr[i][r + 1]), q = bf2f(nr[i][r]); sh[i] = p + (i == 0 ? mu_wl : i == 1 ? mu_al : i == 2 ? mu_g0 : i == 3 ? mu_g1 : mu_4) * (q - p); }
            La[lane] = f2bf(tanhf_(sh[0]));
            La[64 + lane] = f2bf(sh[1]);
            La[128 + lane] = f2bf(sigmoidf_(sh[2]));
            La[192 + lane] = f2bf(sigmoidf_(sh[3]));
            La[256 + lane] = f2bf(lane < 32 ? sigmoidf_(sh[4]) : (l > 0 ? sh[4] : 0.f));
            La[320 + lane] = 0;
        }
#pragma unroll
        for (int rr = 0; rr < RB / 2; ++rr) { float a[8], b[8], oa[8], ob[8]; unpack8(rlo[rr], a); unpack8(rhi[rr], b);
            const float c[8] = {rc[rr][0].x, rc[rr][0].y, rc[rr][0].z, rc[rr][0].w, rc[rr][1].x, rc[rr][1].y, rc[rr][1].z, rc[rr][1].w};
            const float sn[8] = {rc[rr][2].x, rc[rr][2].y, rc[rr][2].z, rc[rr][2].w, rc[rr][3].x, rc[rr][3].y, rc[rr][3].z, rc[rr][3].w};
#pragma unroll
            for (int e = 0; e < 8; ++e) { oa[e] = a[e] * c[e] - b[e] * sn[e]; ob[e] = b[e] * c[e] + a[e] * sn[e]; }
            *(v4u*)(Prot + rr * 2 * PP) = pack8(oa); *(v4u*)(Prot + rr * 2 * PP + 8) = pack8(ob); }
    }
    if (m_lo < M && (lane & 3) == 0) atomicMax(kmaxw + kb * 16 + (lane >> 2), __float_as_uint(kmx));
}

__device__ __forceinline__ float gelu_tanh_(float a) { const float u = 0.7978845608028654f * (a + 0.044715f * a * a * a); return a * __builtin_amdgcn_rcpf(1.f + __expf(-2.f * u)); }
__device__ __forceinline__ void ph_act(KA A, const Ctx& C, int l) {
    const bf16* UP = (const bf16*)(A->ws + WS_UP); bf16* ACT = (bf16*)(A->ws + WS_ACT);
    const float* cw = A->in[29] + (size_t)l * 3 * DFF; const float* cb = A->in[30] + (size_t)l * DFF;
    for (int it = C.gw; it < (M / 32) * 11; it += C.NGW) {
        const int rb = it / 11, cc = it % 11, m0 = rb * 32, col = cc * 512 + C.lane * 8;
        float w0[8], w1[8], w2[8], bb[8];
#pragma unroll
        for (int e = 0; e < 8; ++e) { w0[e] = cw[col + e]; w1[e] = cw[DFF + col + e]; w2[e] = cw[2 * DFF + col + e]; bb[e] = cb[col + e]; }
        float gm2[8], gm1[8];
#pragma unroll
        for (int e = 0; e < 8; ++e) { gm2[e] = 0.f; gm1[e] = 0.f; }
        if ((m0 & (SEQ - 1)) != 0) { unpack8(*(const v4u*)(UP + (size_t)(m0 - 2) * 2 * DFF + col), gm2); unpack8(*(const v4u*)(UP + (size_t)(m0 - 1) * 2 * DFF + col), gm1); }
        for (int i0 = 0; i0 < 32; i0 += 4) {
            v4u gr[4], ur[4];
#pragma unroll
            for (int r = 0; r < 4; ++r) { const size_t ro = (size_t)(m0 + i0 + r) * 2 * DFF; gr[r] = __builtin_nontemporal_load((const v4u*)(UP + ro + col)); ur[r] = __builtin_nontemporal_load((const v4u*)(UP + ro + DFF + col)); }
#pragma unroll
            for (int r = 0; r < 4; ++r) { float g[8], u[8], o[8]; unpack8(gr[r], g); unpack8(ur[r], u);
#pragma unroll
                for (int e = 0; e < 8; ++e) { const float a = w0[e] * gm2[e] + w1[e] * gm1[e] + w2[e] * g[e] + bb[e]; o[e] = gelu_tanh_(a) * u[e]; gm2[e] = gm1[e]; gm1[e] = g[e]; }
                *(v4u*)(ACT + (size_t)(m0 + i0 + r) * DFF + col) = pack8(o); }
        }
    }
}

constexpr int BND_OFF = RING_BYTES + 1024;
constexpr size_t WS_GL = WS_UP, WS_R01 = WS_UP + 4 * MiB;
template <int CTRL> __device__ __forceinline__ float dpp_keep(float old, float src) { return __int_as_float(__builtin_amdgcn_update_dpp(__float_as_int(old), __float_as_int(src), CTRL, 0xf, 0xf, false)); }
__device__ __forceinline__ v2u pk4a(const f32x4 x) { v2u o; o.x = cvtpk(x[0], x[1]); o.y = cvtpk(x[2], x[3]); return o; }
struct EpiAct {
    static constexpr bool PERM = true, AFTER_DRAIN = false;
    bf16* ACT; const float* cw; const float* cb; bf16* GL; bf16* R01; LAS float* bnd;
    __device__ __forceinline__ void operator()(const pg8::f32x4 (&acc)[2][2][4][2], const pg8::Unit& u, int wr, int wc, int fr, int fq) const {
        const int c32 = wc * 32 + 8 * fq, ch0 = u.pn * 128 + c32;
        f32x4 w0[2], w1[2], w2[2], bb[2];
#pragma unroll
        for (int n = 0; n < 2; ++n) { w0[n] = *(const f32x4*)(cw + ch0 + 4 * n); w1[n] = *(const f32x4*)(cw + DFF + ch0 + 4 * n); w2[n] = *(const f32x4*)(cw + 2 * DFF + ch0 + 4 * n); bb[n] = *(const f32x4*)(cb + ch0 + 4 * n); }
        if (fr >= 14) {
#pragma unroll
            for (int ai = 0; ai < 2; ++ai)
#pragma unroll
                for (int n = 0; n < 2; ++n) *(LAS f32x4*)(bnd + ((2 * ai + wr) * 2 + (fr - 14)) * 128 + c32 + 4 * n) = acc[ai][0][3][n];
            if (wr == 1) {
                v2u p0 = pk4a(acc[1][0][3][0]), p1 = pk4a(acc[1][0][3][1]); *(v4u*)(GL + ((size_t)u.pm * 2 + (fr - 14)) * DFF + ch0) = (v4u){p0.x, p0.y, p1.x, p1.y}; }
        }
        if (wr == 0 && fr < 2) {
            v2u p0 = pk4a(acc[0][0][0][0]), p1 = pk4a(acc[0][0][0][1]); *(v4u*)(R01 + (((size_t)u.pm * 2 + fr) * 2 + 0) * DFF + ch0) = (v4u){p0.x, p0.y, p1.x, p1.y};
            p0 = pk4a(acc[0][1][0][0]); p1 = pk4a(acc[0][1][0][1]); *(v4u*)(R01 + (((size_t)u.pm * 2 + fr) * 2 + 1) * DFF + ch0) = (v4u){p0.x, p0.y, p1.x, p1.y}; }
        asm volatile("s_waitcnt lgkmcnt(0)" ::: "memory"); __builtin_amdgcn_s_barrier(); asm volatile("" ::: "memory");
#pragma unroll
        for (int ai = 0; ai < 2; ++ai)
#pragma unroll
            for (int m = 0; m < 4; ++m) {
                float o[8];
#pragma unroll
                for (int n = 0; n < 2; ++n) {
                    const f32x4 g = acc[ai][0][m][n], up = acc[ai][1][m][n]; f32x4 o1, o2;
                    if (m > 0) {
#pragma unroll
                        for (int e = 0; e < 4; ++e) { o1[e] = DPPF(acc[ai][0][m - 1][n][e], 0x121); o2[e] = DPPF(acc[ai][0][m - 1][n][e], 0x122); } }
                    else if (2 * ai + wr == 0) { o1 = (f32x4){0.f, 0.f, 0.f, 0.f}; o2 = o1; }
                    else { const LAS float* bp = bnd + ((2 * ai + wr - 1) * 2) * 128 + c32 + 4 * n; o1 = *(const LAS f32x4*)(bp + 128); o2 = *(const LAS f32x4*)(bp + (fr == 1 ? 128 : 0)); }
#pragma unroll
                    for (int e = 0; e < 4; ++e) { const float p1 = dpp_keep<0x111>(o1[e], g[e]), p2 = dpp_keep<0x112>(o2[e], g[e]);
                        const float a = w0[n][e] * p2 + w1[n][e] * p1 + w2[n][e] * g[e] + bb[n][e];
                        const float ex = __builtin_amdgcn_exp2f(a * fmaf(-0.10294324f, a * a, -2.3022082f)); o[4 * n + e] = (a * up[e]) * __builtin_amdgcn_rcpf(1.f + ex); }
                }
                *(v4u*)(ACT + (size_t)(u.pm * 256 + wr * 64 + fr + ai * 128 + m * 16) * DFF + ch0) = pack8(o);
            }
    }
};
__device__ __forceinline__ void ph_actfix(KA A, const Ctx& C, int l) {
    const bf16* GL = (const bf16*)(A->ws + WS_GL); const bf16* R01 = (const bf16*)(A->ws + WS_R01); bf16* ACT = (bf16*)(A->ws + WS_ACT);
    const float* cw = A->in[29] + (size_t)l * 3 * DFF; const float* cb = A->in[30] + (size_t)l * DFF;
    for (int i = C.gw * 64 + C.lane; i < (M / 256) * (DFF / 8); i += C.NGW * 64) {
        const int pm = i / (DFF / 8), ch0 = (i % (DFF / 8)) * 8; const bool hp = (pm % (SEQ / 256)) != 0;
        float g0[8], g1[8], u0[8], u1[8], q1[8], q2[8], w0[8], w1[8], w2[8], bb[8];
        unpack8(*(const v4u*)(R01 + (((size_t)pm * 2 + 0) * 2 + 0) * DFF + ch0), g0); unpack8(*(const v4u*)(R01 + (((size_t)pm * 2 + 0) * 2 + 1) * DFF + ch0), u0);
        unpack8(*(const v4u*)(R01 + (((size_t)pm * 2 + 1) * 2 + 0) * DFF + ch0), g1); unpack8(*(const v4u*)(R01 + (((size_t)pm * 2 + 1) * 2 + 1) * DFF + ch0), u1);
        if (hp) { unpack8(*(const v4u*)(GL + ((size_t)(pm - 1) * 2 + 1) * DFF + ch0), q1); unpack8(*(const v4u*)(GL + ((size_t)(pm - 1) * 2 + 0) * DFF + ch0), q2); }
        else {
#pragma unroll
            for (int e = 0; e < 8; ++e) { q1[e] = 0.f; q2[e] = 0.f; } }
#pragma unroll
        for (int e = 0; e < 8; ++e) { w0[e] = cw[ch0 + e]; w1[e] = cw[DFF + ch0 + e]; w2[e] = cw[2 * DFF + ch0 + e]; bb[e] = cb[ch0 + e]; }
        float o0[8], o1[8];
#pragma unroll
        for (int e = 0; e < 8; ++e) { o0[e] = gelu_tanh_(w0[e] * q2[e] + w1[e] * q1[e] + w2[e] * g0[e] + bb[e]) * u0[e]; o1[e] = gelu_tanh_(w0[e] * q1[e] + w1[e] * g0[e] + w2[e] * g1[e] + bb[e]) * u1[e]; }
        *(v4u*)(ACT + (size_t)(pm * 256) * DFF + ch0) = pack8(o0); *(v4u*)(ACT + (size_t)(pm * 256 + 1) * DFF + ch0) = pack8(o1);
    }
}

__device__ __forceinline__ int crow(int r, int hi) { return (r & 3) + 8 * (r >> 2) + 4 * hi; }
constexpr int ATT_KROW = 72;
constexpr int ATT_KBUF = 2 * 64 * ATT_KROW * 2, ATT_VBUF = 128 * ATT_KROW * 2;
__device__ __forceinline__ void att_qk(f32x16& s0, f32x16& s1, const LAS unsigned char* kbuf, int mp, const bf16x8* qf, int r32, int hi) {
    s0 = (f32x16){0.f, 0.f, 0.f, 0.f, 0.f, 0.f, 0.f, 0.f, 0.f, 0.f, 0.f, 0.f, 0.f, 0.f, 0.f, 0.f}; s1 = s0;
    const LAS unsigned char* kp = kbuf + ((mp * 64 + r32) * ATT_KROW + hi * 8) * 2;
#pragma unroll
    for (int ks = 0; ks < 4; ++ks) {
        const bf16x8 a0 = *(const LAS bf16x8*)(kp + ks * 32), a1 = *(const LAS bf16x8*)(kp + 32 * ATT_KROW * 2 + ks * 32);
        s0 = __builtin_amdgcn_mfma_f32_32x32x16_bf16(a0, qf[ks], s0, 0, 0, 0);
        s1 = __builtin_amdgcn_mfma_f32_32x32x16_bf16(a1, qf[ks], s1, 0, 0, 0);
    }
}
__device__ __forceinline__ void att_mask(f32x16& s0, f32x16& s1, int kv0, int qa, int hi) {
#pragma unroll
    for (int r = 0; r < 16; ++r) { const int kv = kv0 + crow(r, hi); if (kv > qa) s0[r] = -INFINITY; if (kv + 32 > qa) s1[r] = -INFINITY; }
}
__device__ __forceinline__ void att_stats(const f32x16& s0, const f32x16& s1, float& m, float& l) {
    float tm = fmaxf(s0[0], s1[0]);
#pragma unroll
    for (int r = 1; r < 16; ++r) tm = fmaxf(tm, fmaxf(s0[r], s1[r]));
    tm = fmaxf(tm, __shfl_xor(tm, 32));
    const float mn = fmaxf(m, tm); float acc = 0.f;
#pragma unroll
    for (int r = 0; r < 16; ++r) acc += __builtin_amdgcn_exp2f(s0[r] - mn) + __builtin_amdgcn_exp2f(s1[r] - mn);
    l = l * __builtin_amdgcn_exp2f(m - mn) + acc; m = mn;
}

__device__ __forceinline__ void ph_attn(KA A, const Ctx& C, int l, unsigned* queue  ) {
    const int tid = C.tid, lane = C.lane, wave = C.wave, r32 = lane & 31, hi = lane >> 5;
    const bf16* P = (const bf16*)(A->ws + WS_P); bf16* MIXIN = (bf16*)(A->ws + WS_MIXIN);
    float lam;
    { const float a1 = A->in[22][l * 64 + lane] * A->in[23][l * 64 + lane], a2 = A->in[24][l * 64 + lane] * A->in[25][l * 64 + lane];
      lam = __expf(wave_sum(a1)) - __expf(wave_sum(a2)) + lam_init_of(l); }
    const float oscale = 1.f - lam_init_of(l);
    const float* swp = A->in[26] + l * 128;
    LAS unsigned char* const kbase = C.lds; LAS unsigned char* const vbase = C.lds + 2 * ATT_KBUF;
    const int k_kv = tid >> 4, k_part = tid & 15;
    const unsigned k_goff = (unsigned)(k_kv * PP + k_part * 8) * 2u;
    const int k_loff = (((k_part >> 3) * 64 + k_kv) * ATT_KROW + (k_part & 7) * 8) * 2;
    const int v_kv = tid & 63, v_ch = tid >> 6;
    const unsigned v_goff = (unsigned)(v_kv * PP + v_ch * 8) * 2u;
    const int v_pos = (v_kv & ~12) | ((v_kv & 4) << 1) | ((v_kv & 8) >> 1);
    const int v_loff = (v_ch * 8 * ATT_KROW + v_pos) * 2;
    LAS unsigned* const qslot = (LAS unsigned*)(C.lds + LDSCTL_OFF + 64);
    for (;;) {
        if (tid == 0) *qslot = __hip_atomic_fetch_add(queue, 1u, __ATOMIC_RELAXED, __HIP_MEMORY_SCOPE_AGENT);
        __syncthreads();
        const unsigned u = (unsigned)__builtin_amdgcn_readfirstlane((int)*qslot);
        __syncthreads();
        if (u >= 64u * 16u) break;
        const int bh = (int)(u >> 4), qb = 15 - (int)(u & 15u);
        const int b = bh >> 3, h = bh & 7, q0 = qb * 256, qw = q0 + 32 * wave, qa = qw + r32;
        const bf16* Pb = P + (size_t)b * SEQ * PP;
        const bf16* Kg = Pb + C_KD + h * 128; const bf16* Vg = Pb + C_VD + h * 128;
        bf16x8 qf[2][4];
        { const unsigned qoff = (unsigned)(qa * PP + C_Q + h * 128 + hi * 8) * 2u;
#pragma unroll
          for (int mp = 0; mp < 2; ++mp)
#pragma unroll
              for (int ks = 0; ks < 4; ++ks) qf[mp][ks] = *(const bf16x8*)((const unsigned char*)Pb + (qoff + (unsigned)(mp * 128 + ks * 32))); }
        const int NT = 4 * (qb + 1), my_nt = (qw + 31) / 64 + 1;
        v4u kreg[2], vreg[2];
#define ATT_LOADK(t) do { _Pragma("unroll") for (int i_ = 0; i_ < 2; ++i_) kreg[i_] = *(const v4u*)((const unsigned char*)Kg + (k_goff + (unsigned)(((t) * 64 + 32 * i_) * PP * 2))); } while (0)
#define ATT_STOREK(buf) do { _Pragma("unroll") for (int i_ = 0; i_ < 2; ++i_) *(LAS v4u*)(kbase + (buf) * ATT_KBUF + k_loff + i_ * 32 * ATT_KROW * 2) = kreg[i_]; } while (0)
#define ATT_LOADV(t) do { _Pragma("unroll") for (int i_ = 0; i_ < 2; ++i_) vreg[i_] = *(const v4u*)((const unsigned char*)Vg + (v_goff + (unsigned)((t) * 64 * PP * 2 + i_ * 128))); } while (0)
#define ATT_STOREV(buf) do { _Pragma("unroll") for (int i_ = 0; i_ < 2; ++i_) { LAS unsigned char* vp_ = vbase + (buf) * ATT_VBUF + v_loff + i_ * 64 * ATT_KROW * 2; \
            _Pragma("unroll") for (int e_ = 0; e_ < 8; ++e_) { const unsigned w_ = vreg[i_][e_ >> 1]; *(LAS unsigned short*)(vp_ + e_ * ATT_KROW * 2) = (unsigned short)((e_ & 1) ? (w_ >> 16) : (w_ & 0xffffu)); } } } while (0)
        float m1 = -INFINITY, l1 = 0.f, m2 = -INFINITY, l2 = 0.f;
        ATT_LOADK(0); ATT_STOREK(0); __syncthreads();
        for (int t = 0; t < NT; ++t) {
            if (t + 1 < NT) ATT_LOADK(t + 1);
            if (t < my_nt) {
                const LAS unsigned char* kb = kbase + (t & 1) * ATT_KBUF; const bool msk = (t * 64 + 63 > qw);
                f32x16 s0, s1;
                att_qk(s0, s1, kb, 0, qf[0], r32, hi); if (msk) att_mask(s0, s1, t * 64, qa, hi); att_stats(s0, s1, m1, l1);
                att_qk(s0, s1, kb, 1, qf[1], r32, hi); if (msk) att_mask(s0, s1, t * 64, qa, hi); att_stats(s0, s1, m2, l2);
            }
            if (t + 1 < NT) ATT_STOREK((t + 1) & 1);
            __syncthreads();
        }
        l1 += __shfl_xor(l1, 32); l2 += __shfl_xor(l2, 32);
        const float c1 = 1.f / l1, c2 = lam / l2;
        f32x16 o[4];
#pragma unroll
        for (int d0 = 0; d0 < 4; ++d0) o[d0] = (f32x16){0.f, 0.f, 0.f, 0.f, 0.f, 0.f, 0.f, 0.f, 0.f, 0.f, 0.f, 0.f, 0.f, 0.f, 0.f, 0.f};
        ATT_LOADK(0); ATT_LOADV(0); ATT_STOREK(0); ATT_STOREV(0); __syncthreads();
        for (int t = 0; t < NT; ++t) {
            if (t + 1 < NT) { ATT_LOADK(t + 1); ATT_LOADV(t + 1); }
            if (t < my_nt) {
                const LAS unsigned char* kb = kbase + (t & 1) * ATT_KBUF; const LAS unsigned char* vb = vbase + (t & 1) * ATT_VBUF; const bool msk = (t * 64 + 63 > qw);
                f32x16 a0, a1, b0, b1;
                att_qk(a0, a1, kb, 0, qf[0], r32, hi); att_qk(b0, b1, kb, 1, qf[1], r32, hi);
                if (msk) { att_mask(a0, a1, t * 64, qa, hi); att_mask(b0, b1, t * 64, qa, hi); }
#pragma unroll
                for (int r = 0; r < 16; ++r) {
                    a0[r] = __builtin_amdgcn_exp2f(a0[r] - m1) * c1 - __builtin_amdgcn_exp2f(b0[r] - m2) * c2;
                    a1[r] = __builtin_amdgcn_exp2f(a1[r] - m1) * c1 - __builtin_amdgcn_exp2f(b1[r] - m2) * c2;
                }
                bf16x8 pa[4];
#pragma unroll
                for (int s = 0; s < 2; ++s) {
                    v4u w0, w1;
                    w0.x = cvtpk(a0[8 * s + 0], a0[8 * s + 1]); w0.y = cvtpk(a0[8 * s + 2], a0[8 * s + 3]); w0.z = cvtpk(a0[8 * s + 4], a0[8 * s + 5]); w0.w = cvtpk(a0[8 * s + 6], a0[8 * s + 7]);
                    w1.x = cvtpk(a1[8 * s + 0], a1[8 * s + 1]); w1.y = cvtpk(a1[8 * s + 2], a1[8 * s + 3]); w1.z = cvtpk(a1[8 * s + 4], a1[8 * s + 5]); w1.w = cvtpk(a1[8 * s + 6], a1[8 * s + 7]);
                    pa[s] = __builtin_bit_cast(bf16x8, w0); pa[2 + s] = __builtin_bit_cast(bf16x8, w1);
                }
                const LAS unsigned char* vp = vb + (r32 * ATT_KROW + hi * 8) * 2;
#pragma unroll
                for (int d0 = 0; d0 < 4; ++d0)
#pragma unroll
                    for (int kst = 0; kst < 4; ++kst) {
                        const bf16x8 vf = *(const LAS bf16x8*)(vp + d0 * 32 * ATT_KROW * 2 + kst * 32);
                        o[d0] = __builtin_amdgcn_mfma_f32_32x32x16_bf16(pa[kst], vf, o[d0], 0, 0, 0);
                    }
            }
            if (t + 1 < NT) { ATT_STOREK((t + 1) & 1); ATT_STOREV((t + 1) & 1); }
            __syncthreads();
        }
        int lane_e = lane; asm volatile("" : "+v"(lane_e));
        const unsigned obase = (unsigned)(((b * SEQ + qw + 4 * (lane_e >> 5)) * DM + RW + h * 128 + (lane_e & 31)) * 2);
        float sw[4];
#pragma unroll
        for (int d0 = 0; d0 < 4; ++d0) sw[d0] = swp[d0 * 32 + (lane_e & 31)] * oscale;
#pragma unroll
        for (int r = 0; r < 16; ++r) {
            float ss = o[0][r] * o[0][r] + o[1][r] * o[1][r] + o[2][r] * o[2][r] + o[3][r] * o[3][r];
            ss += __shfl_xor(ss, 1); ss += __shfl_xor(ss, 2); ss += __shfl_xor(ss, 4); ss += __shfl_xor(ss, 8); ss += __shfl_xor(ss, 16);
            const float rs = rsqrtf(ss * (1.f / 128.f) + 1e-5f);
            unsigned char* op = (unsigned char*)MIXIN + (obase + (unsigned)(((r & 3) + 8 * (r >> 2)) * DM * 2));
#pragma unroll
            for (int d0 = 0; d0 < 4; ++d0) *(bf16*)(op + d0 * 64) = f2bf(o[d0][r] * rs * sw[d0]);
        }
#undef ATT_LOADK
#undef ATT_STOREK
#undef ATT_LOADV
#undef ATT_STOREV
    }
}


__device__ __forceinline__ void att2_qk(f32x16& s0, f32x16& s1, const LAS unsigned char* kbuf, int mp, const bf16x8 (&qf)[4], int r32, int hi, float nref) {
    s0 = (f32x16){nref, nref, nref, nref, nref, nref, nref, nref, nref, nref, nref, nref, nref, nref, nref, nref}; s1 = s0;
    const LAS unsigned char* kp = kbuf + ((mp * 64 + r32) * ATT_KROW + hi * 8) * 2;
#pragma unroll
    for (int ks = 0; ks < 4; ++ks) s0 = __builtin_amdgcn_mfma_f32_32x32x16_bf16(*(const LAS bf16x8*)(kp + ks * 32), qf[ks], s0, 0, 0, 0);
#pragma unroll
    for (int ks = 0; ks < 4; ++ks) s1 = __builtin_amdgcn_mfma_f32_32x32x16_bf16(*(const LAS bf16x8*)(kp + 32 * ATT_KROW * 2 + ks * 32), qf[ks], s1, 0, 0, 0);
}
__device__ __forceinline__ float att2_sum16(const f32x16& s) {
    return ((s[0] + s[1]) + (s[2] + s[3])) + ((s[4] + s[5]) + (s[6] + s[7])) + (((s[8] + s[9]) + (s[10] + s[11])) + ((s[12] + s[13]) + (s[14] + s[15])));
}
__device__ __forceinline__ void att2_exp(f32x16& s, bool msk, int kvh, int qa, int hi, bf16x8& pa0, bf16x8& pa1) {
    if (msk) {
#pragma unroll
        for (int r = 0; r < 16; ++r) if (kvh + crow(r, hi) > qa) s[r] = -INFINITY; }
#pragma unroll
    for (int r = 0; r < 16; ++r) s[r] = __builtin_amdgcn_exp2f(s[r]);
    v4u w0, w1;
    w0.x = cvtpk(s[0], s[1]); w0.y = cvtpk(s[2], s[3]); w0.z = cvtpk(s[4], s[5]); w0.w = cvtpk(s[6], s[7]);
    w1.x = cvtpk(s[8], s[9]); w1.y = cvtpk(s[10], s[11]); w1.z = cvtpk(s[12], s[13]); w1.w = cvtpk(s[14], s[15]);
    pa0 = __builtin_bit_cast(bf16x8, w0); pa1 = __builtin_bit_cast(bf16x8, w1);
}
constexpr int ATT2_VP = 160, ATT2_VBUF = 64 * ATT2_VP * 2;
typedef short att_s16x4 __attribute__((ext_vector_type(4)));
__device__ __forceinline__ bf16x8 att2_vtr(const LAS unsigned char* p) {
    const att_s16x4 a = __builtin_amdgcn_ds_read_tr16_b64_v4i16((LAS att_s16x4*)p), c = __builtin_amdgcn_ds_read_tr16_b64_v4i16((LAS att_s16x4*)(p + 8 * ATT2_VP * 2));
    return __builtin_shufflevector(a, c, 0, 1, 2, 3, 4, 5, 6, 7);
}
__device__ __forceinline__ void ph_attn2(KA A, const Ctx& C, int l, unsigned* queue) {
    const int tid = C.tid, lane = C.lane, wave = C.wave, r32 = lane & 31, hi = lane >> 5, g = wave >> 1, mp = wave & 1;
    const bf16* P = (const bf16*)(A->ws + WS_P); bf16* MIXIN = (bf16*)(A->ws + WS_MIXIN);
    const float* kmaxf = (const float*)(A->ws + WS_CTL) + CW_KMAX + 128 * l;
    float lam;
    { const float a1 = A->in[22][l * 64 + lane] * A->in[23][l * 64 + lane], a2 = A->in[24][l * 64 + lane] * A->in[25][l * 64 + lane];
      lam = __expf(wave_sum(a1)) - __expf(wave_sum(a2)) + lam_init_of(l); }
    const float oscale = 1.f - lam_init_of(l);
    const float* swp = A->in[26] + l * 128;
    LAS unsigned char* const kbase = C.lds; LAS unsigned char* const vbase = C.lds + 2 * ATT_KBUF;
    LAS float* const cscr = (LAS float*)(C.lds + 2 * ATT_KBUF + 2 * ATT2_VBUF) + wave * 32;
    LAS float* const xch = (LAS float*)C.lds + g * 4096 + lane;
    static_assert(4 * 4096 * 4 <= 2 * ATT_KBUF + 2 * ATT2_VBUF, "exchange area");
    const int k_kv = tid >> 4, k_part = tid & 15;
    const unsigned k_goff = (unsigned)(k_kv * PP + k_part * 8) * 2u;
    const int k_loff = (((k_part >> 3) * 64 + k_kv) * ATT_KROW + (k_part & 7) * 8) * 2;
    const int v_kv = tid >> 4, v_part = tid & 15;
    const unsigned v_goff = (unsigned)(v_kv * PP + v_part * 8) * 2u;
    const int v_loff = (v_kv * ATT2_VP + v_part * 8) * 2;
    LAS unsigned* const qslot = (LAS unsigned*)(C.lds + LDSCTL_OFF + 64);
    for (;;) {
        if (tid == 0) *qslot = __hip_atomic_fetch_add(queue, 1u, __ATOMIC_RELAXED, __HIP_MEMORY_SCOPE_AGENT);
        __syncthreads();
        const unsigned u = (unsigned)__builtin_amdgcn_readfirstlane((int)*qslot);
        __syncthreads();
        if (u >= 64u * 32u) break;
        const int bh = (int)(u >> 9) * 16 + (int)(u & 15u), qb = 31 - (int)((u >> 4) & 31u);
        const int b = bh >> 3, h = bh & 7, q0 = qb * 128, qw = q0 + 32 * g, qa = qw + r32;
        const bf16* Pb = P + (size_t)b * SEQ * PP;
        const bf16* Kg = Pb + C_KD + h * 128; const bf16* Vg = Pb + C_VD + h * 128;
        const unsigned qoff = (unsigned)(qa * PP + C_Q + h * 128 + mp * 64 + hi * 8) * 2u;
        bf16x8 qf[4];
#pragma unroll
        for (int ks = 0; ks < 4; ++ks) qf[ks] = *(const bf16x8*)((const unsigned char*)Pb + (qoff + (unsigned)(ks * 32)));
        float ref;
        { float q2 = 0.f;
#pragma unroll
          for (int ks = 0; ks < 4; ++ks) { float f[8]; unpack8(__builtin_bit_cast(v4u, qf[ks]), f);
#pragma unroll
              for (int e = 0; e < 8; ++e) q2 += f[e] * f[e]; }
          q2 += __shfl_xor(q2, 32);
          ref = sqrtf(q2 * kmaxf[b * 16 + h * 2 + mp]) * 1.02f; }
        const int NT = 2 * (qb + 1), my_nt = (qw + 31) / 64 + 1;
        v4u kreg[2], vreg[2];
#define ATT_LOADK(t) do { _Pragma("unroll") for (int i_ = 0; i_ < 2; ++i_) kreg[i_] = *(const v4u*)((const unsigned char*)Kg + (k_goff + (unsigned)(((t) * 64 + 32 * i_) * PP * 2))); } while (0)
#define ATT_STOREK(buf) do { _Pragma("unroll") for (int i_ = 0; i_ < 2; ++i_) *(LAS v4u*)(kbase + (buf) * ATT_KBUF + k_loff + i_ * 32 * ATT_KROW * 2) = kreg[i_]; } while (0)
#define ATT_LOADV(t) do { _Pragma("unroll") for (int i_ = 0; i_ < 2; ++i_) vreg[i_] = *(const v4u*)((const unsigned char*)Vg + (v_goff + (unsigned)(((t) * 64 + 32 * i_) * PP * 2))); } while (0)
#define ATT_STOREV(buf) do { _Pragma("unroll") for (int i_ = 0; i_ < 2; ++i_) *(LAS v4u*)(vbase + (buf) * ATT2_VBUF + v_loff + i_ * 32 * ATT2_VP * 2) = vreg[i_]; } while (0)
        f32x16 o[4]; float lsum = 0.f;
        const float nref = -ref;
#pragma unroll
        for (int d0 = 0; d0 < 4; ++d0) o[d0] = (f32x16){0.f, 0.f, 0.f, 0.f, 0.f, 0.f, 0.f, 0.f, 0.f, 0.f, 0.f, 0.f, 0.f, 0.f, 0.f, 0.f};
        ATT_LOADK(0); ATT_LOADV(0); ATT_STOREK(0); ATT_STOREV(0); __syncthreads();
        for (int t = 0; t < NT; ++t) {
            if (t + 1 < NT) { ATT_LOADK(t + 1); ATT_LOADV(t + 1); }
            if (t < my_nt) {
                const LAS unsigned char* kb = kbase + (t & 1) * ATT_KBUF; const LAS unsigned char* vb = vbase + (t & 1) * ATT2_VBUF; const bool msk = (t * 64 + 63 > qw);
                bf16x8 pa[4]; f32x16 s0, s1;
                const LAS unsigned char* vp = vb + ((4 * hi + ((lane & 15) >> 2)) * ATT2_VP + 16 * ((lane >> 4) & 1) + 4 * (lane & 3)) * 2;
                __builtin_amdgcn_s_setprio(1);
                const LAS unsigned char* kp = kb + ((mp * 64 + r32) * ATT_KROW + hi * 8) * 2;
                bf16x8 kf[8];
#pragma unroll
                for (int ks = 0; ks < 4; ++ks) { kf[ks] = *(const LAS bf16x8*)(kp + ks * 32); kf[4 + ks] = *(const LAS bf16x8*)(kp + 32 * ATT_KROW * 2 + ks * 32); }
                __builtin_amdgcn_sched_barrier(0);
                s0 = (f32x16){nref, nref, nref, nref, nref, nref, nref, nref, nref, nref, nref, nref, nref, nref, nref, nref}; s1 = s0;
#pragma unroll
                for (int ks = 0; ks < 4; ++ks) { s0 = __builtin_amdgcn_mfma_f32_32x32x16_bf16(kf[ks], qf[ks], s0, 0, 0, 0); s1 = __builtin_amdgcn_mfma_f32_32x32x16_bf16(kf[4 + ks], qf[ks], s1, 0, 0, 0); }
                bf16x8 vf[8];
#pragma unroll
                for (int d0 = 0; d0 < 4; ++d0)
#pragma unroll
                    for (int kst = 0; kst < 2; ++kst) vf[d0 * 2 + kst] = att2_vtr(vp + (16 * kst * ATT2_VP + d0 * 32) * 2);
                __builtin_amdgcn_sched_barrier(0);
                att2_exp(s0, msk, t * 64, qa, hi, pa[0], pa[1]);
                lsum += att2_sum16(s0);
#pragma unroll
                for (int d0 = 0; d0 < 4; ++d0)
#pragma unroll
                    for (int kst = 0; kst < 2; ++kst) o[d0] = __builtin_amdgcn_mfma_f32_32x32x16_bf16(pa[kst], vf[d0 * 2 + kst], o[d0], 0, 0, 0);
                __builtin_amdgcn_sched_barrier(0);
                bf16x8 vg[8];
#pragma unroll
                for (int d0 = 0; d0 < 4; ++d0)
#pragma unroll
                    for (int kst = 2; kst < 4; ++kst) vg[d0 * 2 + kst - 2] = att2_vtr(vp + (16 * kst * ATT2_VP + d0 * 32) * 2);
                __builtin_amdgcn_sched_barrier(0);
                att2_exp(s1, msk, t * 64 + 32, qa, hi, pa[2], pa[3]);
                lsum += att2_sum16(s1);
#pragma unroll
                for (int d0 = 0; d0 < 4; ++d0)
#pragma unroll
                    for (int kst = 2; kst < 4; ++kst) o[d0] = __builtin_amdgcn_mfma_f32_32x32x16_bf16(pa[kst], vg[d0 * 2 + kst - 2], o[d0], 0, 0, 0);
                __builtin_amdgcn_s_setprio(0);
            }
            if (t + 1 < NT) { ATT_STOREK((t + 1) & 1); ATT_STOREV((t + 1) & 1); }
            __syncthreads();
        }
        int lane_e = lane; asm volatile("" : "+v"(lane_e));
        const float fnum = (mp == 0) ? 1.f : lam;
        lsum += __shfl_xor(lsum, 32);
        cscr[r32] = lsum; LDS_WAIT(); asm volatile("" ::: "memory");
#pragma unroll
        for (int r = 0; r < 16; ++r) { const float cf = fnum / cscr[(r & 3) + 8 * (r >> 2) + 4 * (lane_e >> 5)];
#pragma unroll
            for (int d0 = 0; d0 < 4; ++d0) o[d0][r] *= cf; }
        if (mp == 1) {
#pragma unroll
            for (int d0 = 0; d0 < 4; ++d0)
#pragma unroll
                for (int r = 0; r < 16; ++r) xch[(d0 * 16 + r) * 64] = o[d0][r];
        }
        __syncthreads();
        if (mp == 0) {
            const unsigned obase = (unsigned)(((b * SEQ + qw + 4 * (lane_e >> 5)) * DM + RW + h * 128 + (lane_e & 31)) * 2);
            float sw[4];
#pragma unroll
            for (int d0 = 0; d0 < 4; ++d0) sw[d0] = swp[d0 * 32 + (lane_e & 31)] * oscale;
#pragma unroll
            for (int r = 0; r < 16; ++r) {
                float ov[4]; float ss = 0.f;
#pragma unroll
                for (int d0 = 0; d0 < 4; ++d0) { ov[d0] = o[d0][r] - xch[(d0 * 16 + r) * 64]; ss += ov[d0] * ov[d0]; }
                ss += __shfl_xor(ss, 1); ss += __shfl_xor(ss, 2); ss += __shfl_xor(ss, 4); ss += __shfl_xor(ss, 8); ss += __shfl_xor(ss, 16);
                const float rs = rsqrtf(ss * (1.f / 128.f) + 1e-5f);
                unsigned char* op = (unsigned char*)MIXIN + (obase + (unsigned)(((r & 3) + 8 * (r >> 2)) * DM * 2));
#pragma unroll
                for (int d0 = 0; d0 < 4; ++d0) *(bf16*)(op + d0 * 64) = f2bf(ov[d0] * rs * sw[d0]);
            }
        }
        __syncthreads();
#undef ATT_LOADK
#undef ATT_STOREK
#undef ATT_LOADV
#undef ATT_STOREV
    }
}
#ifdef NAIVE_ATTN
__device__ __forceinline__ void ph_attn_naive(KA A, const Ctx& C, int l) {
    const int lane = C.lane;
    const bf16* P = (const bf16*)(A->ws + WS_P); bf16* MIXIN = (bf16*)(A->ws + WS_MIXIN);
    float lam;
    { const float a1 = A->in[22][l * 64 + lane] * A->in[23][l * 64 + lane], a2 = A->in[24][l * 64 + lane] * A->in[25][l * 64 + lane];
      lam = __expf(wave_sum(a1)) - __expf(wave_sum(a2)) + lam_init_of(l); }
    const float oscale = 1.f - lam_init_of(l);
    const float sw0 = A->in[26][l * 128 + lane] * oscale, sw1 = A->in[26][l * 128 + 64 + lane] * oscale;
    LAS float* qs = (LAS float*)(C.lds + C.wave * 1024);
    for (int it = C.gw; it < M * 8; it += C.NGW) {
        const int m = it >> 3, h = it & 7, b = m >> 12, t = m & (SEQ - 1);
        const bf16* Pb = P + (size_t)b * SEQ * PP;
        const bf16* qp = Pb + (size_t)t * PP + C_Q + h * 128;
        qs[lane] = bf2f(qp[lane]); qs[64 + lane] = bf2f(qp[64 + lane]);
        LDS_WAIT(); asm volatile("" ::: "memory");
        float m1 = -INFINITY, l1 = 0.f, m2 = -INFINITY, l2 = 0.f;
        for (int kv = lane; kv <= t; kv += 64) {
            const bf16* kp = Pb + (size_t)kv * PP + C_KD + h * 128; float s1 = 0.f, s2 = 0.f;
#pragma unroll 4
            for (int d8 = 0; d8 < 8; ++d8) { float k1[8], k2[8]; unpack8(*(const v4u*)(kp + d8 * 8), k1); unpack8(*(const v4u*)(kp + 64 + d8 * 8), k2);
#pragma unroll
                for (int e = 0; e < 8; ++e) { s1 += qs[d8 * 8 + e] * k1[e]; s2 += qs[64 + d8 * 8 + e] * k2[e]; } }
            float mn = fmaxf(m1, s1); l1 = l1 * __builtin_amdgcn_exp2f(m1 - mn) + __builtin_amdgcn_exp2f(s1 - mn); m1 = mn;
            mn = fmaxf(m2, s2); l2 = l2 * __builtin_amdgcn_exp2f(m2 - mn) + __builtin_amdgcn_exp2f(s2 - mn); m2 = mn;
        }
        float M1 = m1, M2 = m2;
#pragma unroll
        for (int o = 1; o < 64; o <<= 1) { M1 = fmaxf(M1, __shfl_xor(M1, o)); M2 = fmaxf(M2, __shfl_xor(M2, o)); }
        const float L1 = wave_sum(l1 * __builtin_amdgcn_exp2f(m1 - M1)), L2 = wave_sum(l2 * __builtin_amdgcn_exp2f(m2 - M2));
        const float c1 = 1.f / L1, c2 = lam / L2;
        float o0 = 0.f, o1 = 0.f;
        for (int kv0 = 0; kv0 <= t; kv0 += 64) {
            const int kv = kv0 + lane; float pt = 0.f;
            if (kv <= t) {
                const bf16* kp = Pb + (size_t)kv * PP + C_KD + h * 128; float s1 = 0.f, s2 = 0.f;
#pragma unroll 4
                for (int d8 = 0; d8 < 8; ++d8) { float k1[8], k2[8]; unpack8(*(const v4u*)(kp + d8 * 8), k1); unpack8(*(const v4u*)(kp + 64 + d8 * 8), k2);
#pragma unroll
                    for (int e = 0; e < 8; ++e) { s1 += qs[d8 * 8 + e] * k1[e]; s2 += qs[64 + d8 * 8 + e] * k2[e]; } }
                pt = __builtin_amdgcn_exp2f(s1 - M1) * c1 - __builtin_amdgcn_exp2f(s2 - M2) * c2;
            }
            const int nj = (t - kv0 + 1) < 64 ? (t - kv0 + 1) : 64;
            for (int j = 0; j < nj; ++j) { const float pj = __shfl(pt, j); const bf16* vp = Pb + (size_t)(kv0 + j) * PP + C_VD + h * 128; o0 += pj * bf2f(vp[lane]); o1 += pj * bf2f(vp[64 + lane]); }
        }
        const float rs = rsqrtf(wave_sum(o0 * o0 + o1 * o1) * (1.f / 128.f) + 1e-5f);
        bf16* op = MIXIN + (size_t)m * DM + RW + h * 128;
        op[lane] = f2bf(o0 * rs * sw0); op[64 + lane] = f2bf(o1 * rs * sw1);
        LDS_WAIT(); asm volatile("" ::: "memory");
    }
}
#endif

#ifdef NAIVE_SCAN
__device__ __forceinline__ float nv_shift(const bf16* Pm, int t, int col, float mu) { const float p = bf2f(Pm[col]); const float q = t > 0 ? bf2f(Pm[col - PP]) : 0.f; return p + mu * (q - p); }
__device__ __forceinline__ void ph_scan_naive(KA A, const Ctx& C, int l) {
    if (C.wave != 0) return;
    const int lane = C.lane;
    const bf16* P = (const bf16*)(A->ws + WS_P); bf16* VF = (bf16*)((unsigned char*)A->out + OUT_VF); bf16* MIXIN = (bf16*)(A->ws + WS_MIXIN);
    LAS float* sx = (LAS float*)C.lds;
    LAS float* sv = sx + 320;
    for (int bh = blockIdx.x; bh < BATCH * 16; bh += C.G) {
        const int b = bh >> 4, hd = bh & 15, c = hd * 64 + lane;
        const float* mu = A->in[8] + (size_t)l * 3360; const float* mumv = A->in[9] + (size_t)(l > 0 ? l - 1 : 0) * 32;
        const float* w2 = A->in[11] + (size_t)l * 64 * RW; const float* a2 = A->in[13] + (size_t)l * 64 * RW; const float* g2 = A->in[14] + (size_t)l * 160 * RW; const float* v2 = A->in[21] + (size_t)(l > 0 ? l - 1 : 0) * 32 * RW;
        const float w0c = A->in[10][l * RW + c], a0c = A->in[12][l * RW + c], kkc = A->in[15][l * RW + c], kac = A->in[16][l * RW + c], rkc = A->in[17][l * RW + c];
        const float gnw = A->in[18][l * RW + c], gnb = A->in[19][l * RW + c];
        const float v0c = l > 0 ? A->in[20][(l - 1) * RW + c] : 0.f;
        float S[64];
#pragma unroll
        for (int j = 0; j < 64; ++j) S[j] = 0.f;
        for (int t = 0; t < SEQ; ++t) {
            const size_t m = (size_t)b * SEQ + t; const bf16* Pm = P + m * PP;
            sx[lane] = tanhf(nv_shift(Pm, t, C_WL + lane, mu[C_WL + lane]));
            sx[64 + lane] = nv_shift(Pm, t, C_AL + lane, mu[C_AL + lane]);
            sx[128 + lane] = 1.f / (1.f + expf(-nv_shift(Pm, t, C_GL + lane, mu[C_GL + lane])));
            sx[192 + lane] = 1.f / (1.f + expf(-nv_shift(Pm, t, C_GL + 64 + lane, mu[C_GL + 64 + lane])));
            if (lane < 32) { sx[256 + lane] = 1.f / (1.f + expf(-nv_shift(Pm, t, C_GL + 128 + lane, mu[C_GL + 128 + lane]))); sx[288 + lane] = l > 0 ? nv_shift(Pm, t, C_MV + lane, mumv[lane]) : 0.f; }
            LDS_WAIT(); asm volatile("" ::: "memory");
            float d = w0c, ap = a0c, g = 0.f, vgp = v0c;
#ifdef NAIVE_SCAN_USE_LO
            { const bf16* Lm = (const bf16*)(A->ws + WS_LO) + m * LON; d += bf2f(Lm[c]); ap += bf2f(Lm[RW + c]); g = bf2f(Lm[2 * RW + c]); vgp += bf2f(Lm[3 * RW + c]); }
#else
#pragma unroll 2
            for (int k = 0; k < 64; ++k) { d += sx[k] * w2[(size_t)k * RW + c]; ap += sx[64 + k] * a2[(size_t)k * RW + c]; }
#pragma unroll 2
            for (int k = 0; k < 160; ++k) g += sx[128 + k] * g2[(size_t)k * RW + c];
            if (l > 0) {
#pragma unroll 2
                for (int k = 0; k < 32; ++k) vgp += sx[288 + k] * v2[(size_t)k * RW + c]; }
#endif
            const float r = nv_shift(Pm, t, C_R + c, mu[C_R + c]), k = nv_shift(Pm, t, C_K + c, mu[C_K + c]); float v = nv_shift(Pm, t, C_V + c, mu[C_V + c]);
            const float sp = (-d > 20.f) ? -d : log1pf(expf(-d)); const float w = expf(-expf(-sp - 0.5f));
            const float a = 1.f / (1.f + expf(-ap));
            if (l > 0) { const float vf = bf2f(VF[m * RW + c]); v = v + (vf - v) * (1.f / (1.f + expf(-vgp))); } else VF[m * RW + c] = f2bf(v);
            const float kkr = k * kkc; const float kk = kkr / fmaxf(sqrtf(wave_sum(kkr * kkr)), 1e-12f);
            const float kp = k * (1.f + (a - 1.f) * kac);
            const float bc = wave_sum(r * kp * rkc);
            sv[lane] = w; sv[64 + lane] = kk; sv[128 + lane] = kk * a; sv[192 + lane] = kp; sv[256 + lane] = r;
            LDS_WAIT(); asm volatile("" ::: "memory");
            float sa = 0.f;
#pragma unroll
            for (int j = 0; j < 64; ++j) { sa += S[j] * sv[64 + j]; if ((j & 7) == 7) asm volatile("" ::: "memory"); }
            sa = -sa;
            float ov = 0.f;
#pragma unroll
            for (int j = 0; j < 64; ++j) { S[j] = S[j] * sv[j] + sa * sv[128 + j] + v * sv[192 + j]; ov += S[j] * sv[256 + j]; if ((j & 3) == 3) asm volatile("" ::: "memory"); }
            const float mean = wave_sum(ov) * (1.f / 64.f); const float dv = ov - mean; const float var = wave_sum(dv * dv) * (1.f / 64.f);
            float y = dv * rsqrtf(var + 64e-5f) * gnw + gnb;
            y = (y + bc * v) * g;
            MIXIN[m * DM + c] = f2bf(y);
            LDS_WAIT(); asm volatile("" ::: "memory");
        }
    }
}
#endif

#ifdef NAIVE_LORA
#ifdef NAIVE_LORA_RND
#define NVR(x) bf2f(f2bf(x))
#else
#define NVR(x) (x)
#endif
__device__ __forceinline__ void ph_lora_naive(KA A, const Ctx& C, int l) {
    const bf16* LA = (const bf16*)(A->ws + WS_LA); bf16* LO = (bf16*)(A->ws + WS_LO);
    const float* w2 = A->in[11] + (size_t)l * 64 * RW; const float* a2 = A->in[13] + (size_t)l * 64 * RW; const float* g2 = A->in[14] + (size_t)l * 160 * RW; const float* v2 = A->in[21] + (size_t)(l > 0 ? l - 1 : 0) * 32 * RW;
    for (int m = blockIdx.x; m < M; m += C.G) {
        const bf16* La = LA + (size_t)m * LAK;
        for (int n = C.tid; n < LON; n += NWAVES * 64) {
            const int blk = n >> 10, nn = n & 1023; float acc = 0.f;
#ifdef NAIVE_LORA_USE_WL
            { const bf16* Wn = (const bf16*)(A->ws + WS_WL) + (size_t)n * LAK; for (int k = 0; k < LAK; ++k) acc += bf2f(La[k]) * bf2f(Wn[k]); }
            if (true) {}
            else if (blk == 0)
#else
            if (blk == 0)
#endif
            { for (int k = 0; k < 64; ++k) acc += bf2f(La[k]) * NVR(w2[(size_t)k * RW + nn]); }
            else if (blk == 1) { for (int k = 0; k < 64; ++k) acc += bf2f(La[64 + k]) * NVR(a2[(size_t)k * RW + nn]); }
            else if (blk == 2) { for (int k = 0; k < 160; ++k) acc += bf2f(La[128 + k]) * NVR(g2[(size_t)k * RW + nn]); }
            else if (l > 0) { for (int k = 0; k < 32; ++k) acc += bf2f(La[288 + k]) * NVR(v2[(size_t)k * RW + nn]); }
            LO[(size_t)m * LON + n] = f2bf(acc);
        }
    }
}
#endif
__device__ __forceinline__ float red8(float x) { x += DPPF(x, 0xB1); x += DPPF(x, 0x4E); x += DPPF(x, 0x141); return x; }
constexpr int SC_T = 32;
__device__ __forceinline__ void ph_scan(KA A, const Ctx& C, int l) {
    const int lane = C.lane, wave = C.wave;
    const bf16* P = (const bf16*)(A->ws + WS_P); const bf16* LO = (const bf16*)(A->ws + WS_LO); bf16* VF = (bf16*)((unsigned char*)A->out + OUT_VF); bf16* MIXIN = (bf16*)(A->ws + WS_MIXIN);
    LAS float* sW = (LAS float*)C.lds; LAS float* sKK = sW + SC_T * 64; LAS float* sBB = sKK + SC_T * 64; LAS float* sKP = sBB + SC_T * 64; LAS float* sR = sKP + SC_T * 64;
    LAS float* sV = sR + SC_T * 64; LAS float* sG = sV + SC_T * 64; LAS float* sO = sG + SC_T * 64; LAS float* sBC = sO + SC_T * 64;
    const int il = lane >> 3, jg = lane & 7, irow = wave * 8 + il;
    for (int bh = blockIdx.x; bh < BATCH * 16; bh += C.G) {
        const int b = bh >> 4, hd = bh & 15, c = hd * 64 + lane;
        const float* mu = A->in[8] + (size_t)l * 3360;
        const float mu_r = mu[C_R + c], mu_k = mu[C_K + c], mu_v = mu[C_V + c];
        const float w0c = A->in[10][l * RW + c], a0c = A->in[12][l * RW + c], kkc = A->in[15][l * RW + c], kac = A->in[16][l * RW + c], rkc = A->in[17][l * RW + c];
        const float gnw = A->in[18][l * RW + c], gnb = A->in[19][l * RW + c];
        const float v0c = l > 0 ? A->in[20][(l - 1) * RW + c] : 0.f;
        float S[8];
#pragma unroll
        for (int e = 0; e < 8; ++e) S[e] = 0.f;
        for (int ch = 0; ch < SEQ / SC_T; ++ch) {
#pragma unroll 1
            for (int s = 0; s < SC_T / 8; ++s) {
                const int tl = wave * (SC_T / 8) + s, t = ch * SC_T + tl; const size_t m = (size_t)b * SEQ + t;
                const bf16* Pm = P + m * PP;
                const float pr = bf2f(Pm[C_R + c]), pk = bf2f(Pm[C_K + c]), pv = bf2f(Pm[C_V + c]);
                float qr = 0.f, qk = 0.f, qv = 0.f;
                if (t > 0) { qr = bf2f(Pm[C_R + c - PP]); qk = bf2f(Pm[C_K + c - PP]); qv = bf2f(Pm[C_V + c - PP]); }
                const float r = pr + mu_r * (qr - pr), k = pk + mu_k * (qk - pk); float v = pv + mu_v * (qv - pv);
                const bf16* Lm = LO + m * LON;
                const float d = w0c + bf2f(Lm[c]);
                const float w = __expf(-0.6065306597126334f * sigmoidf_(d));
                const float a = sigmoidf_(a0c + bf2f(Lm[RW + c]));
                const float g = bf2f(Lm[2 * RW + c]);
                if (l > 0) { const float vf = bf2f(VF[m * RW + c]); const float vg = sigmoidf_(v0c + bf2f(Lm[3 * RW + c])); v = v + (vf - v) * vg; }
                else VF[m * RW + c] = f2bf(v);
                const float kkr = k * kkc; const float n2 = wave_sum(kkr * kkr); const float kk = kkr / fmaxf(sqrtf(n2), 1e-12f);
                const float kp = k * (1.f + (a - 1.f) * kac);
                const float bc = wave_sum(r * kp * rkc);
                sW[tl * 64 + lane] = w; sKK[tl * 64 + lane] = kk; sBB[tl * 64 + lane] = kk * a; sKP[tl * 64 + lane] = kp; sR[tl * 64 + lane] = r; sV[tl * 64 + lane] = v; sG[tl * 64 + lane] = g;
                if (lane == 0) sBC[tl] = bc;
            }
            __syncthreads();
#pragma unroll 2
            for (int tl = 0; tl < SC_T; ++tl) {
                const int o8 = tl * 64 + jg * 8;
                const f32x4 w0 = *(const LAS f32x4*)(sW + o8), w1 = *(const LAS f32x4*)(sW + o8 + 4), k0 = *(const LAS f32x4*)(sKK + o8), k1 = *(const LAS f32x4*)(sKK + o8 + 4);
                const f32x4 b0 = *(const LAS f32x4*)(sBB + o8), b1 = *(const LAS f32x4*)(sBB + o8 + 4), p0 = *(const LAS f32x4*)(sKP + o8), p1 = *(const LAS f32x4*)(sKP + o8 + 4);
                const f32x4 r0 = *(const LAS f32x4*)(sR + o8), r1 = *(const LAS f32x4*)(sR + o8 + 4);
                const float vi = sV[tl * 64 + irow];
                float sa = (S[0] * k0.x + S[1] * k0.y) + (S[2] * k0.z + S[3] * k0.w) + (S[4] * k1.x + S[5] * k1.y) + (S[6] * k1.z + S[7] * k1.w);
                sa = -red8(sa);
                S[0] = S[0] * w0.x + sa * b0.x + vi * p0.x; S[1] = S[1] * w0.y + sa * b0.y + vi * p0.y; S[2] = S[2] * w0.z + sa * b0.z + vi * p0.z; S[3] = S[3] * w0.w + sa * b0.w + vi * p0.w;
                S[4] = S[4] * w1.x + sa * b1.x + vi * p1.x; S[5] = S[5] * w1.y + sa * b1.y + vi * p1.y; S[6] = S[6] * w1.z + sa * b1.z + vi * p1.z; S[7] = S[7] * w1.w + sa * b1.w + vi * p1.w;
                float ov = (S[0] * r0.x + S[1] * r0.y) + (S[2] * r0.z + S[3] * r0.w) + (S[4] * r1.x + S[5] * r1.y) + (S[6] * r1.z + S[7] * r1.w);
                ov = red8(ov);
                if (jg == 0) sO[tl * 64 + irow] = ov;
            }
            __syncthreads();
#pragma unroll 1
            for (int s = 0; s < SC_T / 8; ++s) {
                const int tl = wave * (SC_T / 8) + s, t = ch * SC_T + tl; const size_t m = (size_t)b * SEQ + t;
                const float ov = sO[tl * 64 + lane]; const float mean = wave_sum(ov) * (1.f / 64.f); const float dv = ov - mean; const float var = wave_sum(dv * dv) * (1.f / 64.f);
                float y = dv * rsqrtf(var + 64e-5f) * gnw + gnb;
                y = (y + sBC[tl] * sV[tl * 64 + lane]) * sG[tl * 64 + lane];
                MIXIN[m * DM + c] = f2bf(y);
            }
            __syncthreads();
        }
    }
}


__device__ __forceinline__ float wave_sum_dpp(float x) {
    x += DPPF(x, 0xB1); x += DPPF(x, 0x4E); x += DPPF(x, 0x141); x += DPPF(x, 0x140);
    const int xi = __float_as_int(x);
    const float s0 = __int_as_float(__builtin_amdgcn_readlane(xi, 0)), s1 = __int_as_float(__builtin_amdgcn_readlane(xi, 16)), s2 = __int_as_float(__builtin_amdgcn_readlane(xi, 32)), s3 = __int_as_float(__builtin_amdgcn_readlane(xi, 48));
    return (s0 + s1) + (s2 + s3);
}
constexpr int SC2_T = 16, SC2_NC = SEQ / SC2_T, SC2_VEC = SC2_T * 64;
constexpr int SC2_IN_B = 5 * SC2_VEC * 2 + SC2_VEC * 4, SC2_OUT_B = SC2_VEC * 4, SC2_GG_B = 2 * SC2_VEC * 4;
typedef _Float16 h2_t __attribute__((ext_vector_type(2)));
typedef _Float16 h4_t __attribute__((ext_vector_type(4)));
typedef _Float16 h8_t __attribute__((ext_vector_type(8)));
constexpr int SC2_OFF_IN = 0, SC2_OFF_OUT = 2 * SC2_IN_B, SC2_OFF_GG = SC2_OFF_OUT + 2 * SC2_OUT_B;
static_assert(SC2_OFF_GG + 3 * SC2_GG_B <= RING_BYTES && (SC2_IN_B % 16) == 0, "scan LDS map");
__device__ __forceinline__ float row16_sum(float x) { x += DPPF(x, 0xB1); x += DPPF(x, 0x4E); x += DPPF(x, 0x141); x += DPPF(x, 0x140); return x; }

struct Sc2In { h8_t u0, u1, k0, k1, b0, b1, q0, q1, x0, x1; float vv; };
__device__ __forceinline__ void sc2_read(Sc2In& X, const LAS unsigned char* in, int t, int cq, int irow) {
    const LAS _Float16* p = (const LAS _Float16*)in + t * 64 + cq * 16;
    X.u0 = *(const LAS h8_t*)(p); X.u1 = *(const LAS h8_t*)(p + 8); X.k0 = *(const LAS h8_t*)(p + SC2_VEC); X.k1 = *(const LAS h8_t*)(p + SC2_VEC + 8);
    X.b0 = *(const LAS h8_t*)(p + 2 * SC2_VEC); X.b1 = *(const LAS h8_t*)(p + 2 * SC2_VEC + 8); X.q0 = *(const LAS h8_t*)(p + 3 * SC2_VEC); X.q1 = *(const LAS h8_t*)(p + 3 * SC2_VEC + 8);
    X.x0 = *(const LAS h8_t*)(p + 4 * SC2_VEC); X.x1 = *(const LAS h8_t*)(p + 4 * SC2_VEC + 8);
    X.vv = *((const LAS float*)(in + 5 * SC2_VEC * 2) + t * 64 + irow);
}
#define H2AT(v, e) ((h2_t){(v)[2 * (e)], (v)[2 * (e) + 1]})
__device__ __forceinline__ float quad_sum(float x) { x += DPPF(x, 0xB1); x += DPPF(x, 0x4E); return x; }
__device__ __forceinline__ void sc2_step(h2_t (&S)[8], const Sc2In& X, LAS float* out, int t, int cq, int irow) {
    float a0 = 0.f, a1 = 0.f;
#pragma unroll
    for (int e = 0; e < 4; ++e) { a0 = __builtin_amdgcn_fdot2(S[e], H2AT(X.k0, e), a0, false); a1 = __builtin_amdgcn_fdot2(S[4 + e], H2AT(X.k1, e), a1, false); }
    const float sa = -quad_sum(a0 + a1);
    const h2_t sav = {(_Float16)sa, (_Float16)sa}, vv2 = {(_Float16)X.vv, (_Float16)X.vv};
#pragma unroll
    for (int e = 0; e < 4; ++e) {
        S[e] = ((S[e] - S[e] * H2AT(X.u0, e)) + vv2 * H2AT(X.q0, e)) + sav * H2AT(X.b0, e);
        S[4 + e] = ((S[4 + e] - S[4 + e] * H2AT(X.u1, e)) + vv2 * H2AT(X.q1, e)) + sav * H2AT(X.b1, e); }
    float o0 = 0.f, o1 = 0.f;
#pragma unroll
    for (int e = 0; e < 4; ++e) { o0 = __builtin_amdgcn_fdot2(S[e], H2AT(X.x0, e), o0, false); o1 = __builtin_amdgcn_fdot2(S[4 + e], H2AT(X.x1, e), o1, false); }
    const float oo = quad_sum(o0 + o1);
    if (cq == 0) out[t * 64 + irow] = oo;
}
__device__ __forceinline__ void scan2_scanner(LAS unsigned char* lds, int wave, int lane) {
    const int cq = lane & 3, irow = wave * 16 + (lane >> 2);
    h2_t S[8];
#pragma unroll
    for (int e = 0; e < 8; ++e) S[e] = (h2_t){(_Float16)0.f, (_Float16)0.f};
    __syncthreads();
    for (int c = 0; c < SC2_NC; ++c) {
        const LAS unsigned char* in = lds + SC2_OFF_IN + (c & 1) * SC2_IN_B;
        LAS float* out = (LAS float*)(lds + SC2_OFF_OUT + (c & 1) * SC2_OUT_B);
        Sc2In XA, XB;
        sc2_read(XA, in, 0, cq, irow);
#pragma unroll 2
        for (int t = 0; t < SC2_T; t += 2) {
            sc2_read(XB, in, t + 1, cq, irow);
            sc2_step(S, XA, out, t, cq, irow);
            if (t + 2 < SC2_T) sc2_read(XA, in, t + 2, cq, irow);
            sc2_step(S, XB, out, t + 1, cq, irow);
        }
        __syncthreads();
    }
}

__device__ __forceinline__ f32x4 up4(const v2u v) { return (f32x4){bf_lo(v.x), bf_hi(v.x), bf_lo(v.y), bf_hi(v.y)}; }
struct Sc2Raw { v2u pr, pk, pv, qr, qk, qv, ld, la, lg, lv, vf; };
struct Sc2Par { f32x4 mu_r, mu_k, mu_v, w0c, a0c, kkc, kac, rkc, gnw, gnb, v0c; const unsigned char* P; const unsigned char* LO; unsigned char* VF; unsigned char* MIXIN; unsigned mb, offP; int tl, q4, l; };
__device__ __forceinline__ void sc2_load(Sc2Raw& R, const Sc2Par& p, int c) {
    const unsigned m = p.mb + (unsigned)(c * SC2_T) + (unsigned)p.tl; const unsigned char* Pm = p.P + (size_t)m * (PP * 2); const unsigned char* Lm = p.LO + (size_t)m * (LON * 2);
    const v2u zero2 = {0u, 0u};
    R.pr = __builtin_nontemporal_load((const v2u*)(Pm + C_R * 2 + p.offP)); R.pk = __builtin_nontemporal_load((const v2u*)(Pm + C_K * 2 + p.offP)); R.pv = __builtin_nontemporal_load((const v2u*)(Pm + C_V * 2 + p.offP));
    if (c * SC2_T + p.tl > 0) { R.qr = __builtin_nontemporal_load((const v2u*)(Pm - PP * 2 + C_R * 2 + p.offP)); R.qk = __builtin_nontemporal_load((const v2u*)(Pm - PP * 2 + C_K * 2 + p.offP)); R.qv = __builtin_nontemporal_load((const v2u*)(Pm - PP * 2 + C_V * 2 + p.offP)); } else { R.qr = zero2; R.qk = zero2; R.qv = zero2; }
    R.ld = __builtin_nontemporal_load((const v2u*)(Lm + p.offP)); R.la = __builtin_nontemporal_load((const v2u*)(Lm + RW * 2 + p.offP)); R.lg = __builtin_nontemporal_load((const v2u*)(Lm + 2 * RW * 2 + p.offP)); R.lv = __builtin_nontemporal_load((const v2u*)(Lm + 3 * RW * 2 + p.offP));
    R.vf = (p.l > 0) ? __builtin_nontemporal_load((const v2u*)(p.VF + (size_t)m * (RW * 2) + p.offP)) : zero2;
}
__device__ __forceinline__ void sc2_stage(const Sc2Raw& R, const Sc2Par& p, LAS unsigned char* lds, int c, int gi) {
    LAS _Float16* inh = (LAS _Float16*)(lds + SC2_OFF_IN + (c & 1) * SC2_IN_B) + p.tl * 64 + p.q4; LAS float* inv = (LAS float*)(lds + SC2_OFF_IN + (c & 1) * SC2_IN_B + 5 * SC2_VEC * 2) + p.tl * 64 + p.q4;
    LAS float* gg = (LAS float*)(lds + SC2_OFF_GG + gi * SC2_GG_B) + p.tl * 64 + p.q4;
    const f32x4 cr = up4(R.pr), ck = up4(R.pk), cv = up4(R.pv);
    const f32x4 r = cr + p.mu_r * (up4(R.qr) - cr), k = ck + p.mu_k * (up4(R.qk) - ck); f32x4 v = cv + p.mu_v * (up4(R.qv) - cv);
    const f32x4 d = p.w0c + up4(R.ld), ap = p.a0c + up4(R.la), g = up4(R.lg); f32x4 w, a;
#pragma unroll
    for (int e = 0; e < 4; ++e) { w[e] = 1.f - __expf(-0.6065306597126334f * sigmoidf_(d[e])); a[e] = sigmoidf_(ap[e]); }
    if (p.l > 0) { const f32x4 vg = p.v0c + up4(R.lv), vf = up4(R.vf);
#pragma unroll
        for (int e = 0; e < 4; ++e) v[e] = v[e] + (vf[e] - v[e]) * sigmoidf_(vg[e]); }
    else { v2u o; o.x = cvtpk(v[0], v[1]); o.y = cvtpk(v[2], v[3]); *(v2u*)(p.VF + (size_t)(p.mb + (unsigned)(c * SC2_T) + (unsigned)p.tl) * (RW * 2) + p.offP) = o; }
    const f32x4 kkr = k * p.kkc; const float n2 = row16_sum((kkr[0] * kkr[0] + kkr[1] * kkr[1]) + (kkr[2] * kkr[2] + kkr[3] * kkr[3]));
    const f32x4 kk = kkr * __builtin_amdgcn_rsqf(fmaxf(n2, 1e-24f)); const f32x4 kp = k * (1.f + (a - 1.f) * p.kac); const f32x4 rk = r * kp * p.rkc;
    const float bc = row16_sum((rk[0] + rk[1]) + (rk[2] + rk[3]));
    const f32x4 bb = kk * a;
    *(LAS h4_t*)(inh) = __builtin_convertvector(w, h4_t); *(LAS h4_t*)(inh + SC2_VEC) = __builtin_convertvector(kk, h4_t); *(LAS h4_t*)(inh + 2 * SC2_VEC) = __builtin_convertvector(bb, h4_t);
    *(LAS h4_t*)(inh + 3 * SC2_VEC) = __builtin_convertvector(kp, h4_t); *(LAS h4_t*)(inh + 4 * SC2_VEC) = __builtin_convertvector(r, h4_t); *(LAS f32x4*)(inv) = v;
    *(LAS f32x4*)(gg) = p.gnw * g; *(LAS f32x4*)(gg + SC2_VEC) = (p.gnb + bc * v) * g;
}
__device__ __forceinline__ void sc2_post(const Sc2Par& p, LAS unsigned char* lds, int c, int gi) {
    const LAS float* out = (const LAS float*)(lds + SC2_OFF_OUT + (c & 1) * SC2_OUT_B) + p.tl * 64 + p.q4; const LAS float* gg = (const LAS float*)(lds + SC2_OFF_GG + gi * SC2_GG_B) + p.tl * 64 + p.q4;
    const f32x4 o = *(const LAS f32x4*)(out); const float s1 = row16_sum((o[0] + o[1]) + (o[2] + o[3])), s2 = row16_sum((o[0] * o[0] + o[1] * o[1]) + (o[2] * o[2] + o[3] * o[3]));
    const float mean = s1 * (1.f / 64.f); const float rs = __builtin_amdgcn_rsqf(fmaxf(s2 * (1.f / 64.f) - mean * mean, 0.f) + 64e-5f);
    const f32x4 y = (o - mean) * rs * *(const LAS f32x4*)(gg) + *(const LAS f32x4*)(gg + SC2_VEC); v2u w2; w2.x = cvtpk(y[0], y[1]); w2.y = cvtpk(y[2], y[3]);
    *(v2u*)(p.MIXIN + (size_t)(p.mb + (unsigned)(c * SC2_T) + (unsigned)p.tl) * (DM * 2) + p.offP) = w2;
}
__device__ __forceinline__ void scan2_stager(KA A, LAS unsigned char* lds, int sw, int lane, int l, int b, int hd) {
    Sc2Par p;
    p.P = (const unsigned char*)(A->ws + WS_P); p.LO = (const unsigned char*)(A->ws + WS_LO); p.VF = (unsigned char*)((unsigned char*)A->out + OUT_VF); p.MIXIN = (unsigned char*)(A->ws + WS_MIXIN);
    const int st = lane >> 4; p.q4 = (lane & 15) * 4; const int cc = hd * 64 + p.q4; p.tl = 4 * sw + st; p.l = l;
    const float* mu = A->in[8] + (size_t)l * 3360;
    p.mu_r = *(const f32x4*)(mu + C_R + cc); p.mu_k = *(const f32x4*)(mu + C_K + cc); p.mu_v = *(const f32x4*)(mu + C_V + cc);
    p.w0c = *(const f32x4*)(A->in[10] + l * RW + cc); p.a0c = *(const f32x4*)(A->in[12] + l * RW + cc); p.kkc = *(const f32x4*)(A->in[15] + l * RW + cc); p.kac = *(const f32x4*)(A->in[16] + l * RW + cc);
    p.rkc = *(const f32x4*)(A->in[17] + l * RW + cc); p.gnw = *(const f32x4*)(A->in[18] + l * RW + cc); p.gnb = *(const f32x4*)(A->in[19] + l * RW + cc);
    p.v0c = l > 0 ? *(const f32x4*)(A->in[20] + (l - 1) * RW + cc) : (f32x4){0.f, 0.f, 0.f, 0.f};
    p.mb = (unsigned)b * SEQ; p.offP = (unsigned)cc * 2u;
    Sc2Raw R0, R1, R2;
    sc2_load(R0, p, 0); sc2_load(R1, p, 1); sc2_load(R2, p, 2);
    sc2_stage(R0, p, lds, 0, 0); sc2_load(R0, p, 3);
    __syncthreads();
#define SC2_BODY(ci, RN, sn, sp) do { if ((ci) < SC2_NC) { if ((ci) + 1 < SC2_NC) sc2_stage(RN, p, lds, (ci) + 1, sn); if ((ci) + 4 < SC2_NC) sc2_load(RN, p, (ci) + 4); if ((ci) >= 1) sc2_post(p, lds, (ci) - 1, sp); __syncthreads(); } } while (0)
    for (int c = 0; c < SC2_NC; c += 3) { SC2_BODY(c, R1, 1, 2); SC2_BODY(c + 1, R2, 2, 0); SC2_BODY(c + 2, R0, 0, 1); }
#undef SC2_BODY
    sc2_post(p, lds, SC2_NC - 1, (SC2_NC - 1) % 3);
}


constexpr int S3_AR = 0, S3_BK = 4608, S3_BKT = 9216, S3_UVT = 14336, S3_PC = 19456, S3_SET = 19712;
constexpr int S3_OFF_LW = 2 * S3_SET, S3_OFF_LM = S3_OFF_LW + 2 * 4096, S3_OFF_GS = S3_OFF_LM + 4608, S3_OFF_OUT = S3_OFF_GS + 8192, S3_OFF_GG = S3_OFF_OUT + 2 * SC2_OUT_B, S3_OFF_LMB = S3_OFF_GG + 4 * SC2_GG_B;
static_assert(S3_OFF_LMB + 2560 <= RING_BYTES && (S3_OFF_LW % 16) == 0 && (S3_OFF_LM % 16) == 0 && (S3_OFF_LMB % 16) == 0, "chunked scan LDS map");
struct Sc3Keep { f32x4 lw, cw, kk, bb, kp, r, v; };
__device__ __forceinline__ v2u pk4(const f32x4 x) { v2u o; o.x = cvtpk(x[0], x[1]); o.y = cvtpk(x[2], x[3]); return o; }
__device__ __forceinline__ void sc3_phaseA(const Sc2Raw& R, const Sc2Par& p, LAS unsigned char* lds, int c, int gi, Sc3Keep& K) {
    LAS float* gg = (LAS float*)(lds + S3_OFF_GG + gi * SC2_GG_B) + p.tl * 64 + p.q4;
    const f32x4 cr = up4(R.pr), ck = up4(R.pk), cv = up4(R.pv);
    const f32x4 r = cr + p.mu_r * (up4(R.qr) - cr), k = ck + p.mu_k * (up4(R.qk) - ck); f32x4 v = cv + p.mu_v * (up4(R.qv) - cv);
    const f32x4 d = p.w0c + up4(R.ld), ap = p.a0c + up4(R.la), g = up4(R.lg); f32x4 lw, a;
#pragma unroll
    for (int e = 0; e < 4; ++e) { lw[e] = (-0.6065306597126334f * 1.4426950408889634f) * sigmoidf_(d[e]); a[e] = sigmoidf_(ap[e]); }
    LAS float* const lwrow = (LAS float*)(lds + S3_OFF_LW + (c & 1) * 4096) + p.q4;
    *(LAS f32x4*)(lwrow + p.tl * 64) = lw;
    if (p.l > 0) { const f32x4 vg = p.v0c + up4(R.lv), vf = up4(R.vf);
#pragma unroll
        for (int e = 0; e < 4; ++e) v[e] = v[e] + (vf[e] - v[e]) * sigmoidf_(vg[e]); }
    else *(v2u*)(p.VF + (size_t)(p.mb + (unsigned)(c * SC2_T) + (unsigned)p.tl) * (RW * 2) + p.offP) = pk4(v);
    const f32x4 kkr = k * p.kkc; const float n2 = row16_sum((kkr[0] * kkr[0] + kkr[1] * kkr[1]) + (kkr[2] * kkr[2] + kkr[3] * kkr[3]));
    const f32x4 kk = kkr * __builtin_amdgcn_rsqf(fmaxf(n2, 1e-24f)); const f32x4 kp = k * (1.f + (a - 1.f) * p.kac); const f32x4 rk = r * kp * p.rkc;
    const float bc = row16_sum((rk[0] + rk[1]) + (rk[2] + rk[3]));
    *(LAS f32x4*)(gg) = p.gnw * g; *(LAS f32x4*)(gg + SC2_VEC) = (p.gnb + bc * v) * g;
    LDS_WAIT(); asm volatile("" ::: "memory");
    f32x4 cw = lw; const int st = p.tl & 3;
#pragma unroll
    for (int j = 0; j < 3; ++j) { const f32x4 x = *(const LAS f32x4*)(lwrow + ((p.tl & ~3) + j) * 64); if (j < st) cw += x; }
    LDS_WAIT(); asm volatile("" ::: "memory");
    *(LAS f32x4*)(lwrow + p.tl * 64) = cw;
    K.lw = lw; K.cw = cw; K.kk = kk; K.bb = kk * a; K.kp = kp; K.r = r; K.v = v;
}
__device__ __forceinline__ void sc3_phaseB(const Sc3Keep& K, const Sc2Par& p, LAS unsigned char* lds, int c) {
    const LAS float* lwp = (const LAS float*)(lds + S3_OFF_LW + (c & 1) * 4096) + p.q4; f32x4 cum = K.cw;
#pragma unroll
    for (int j = 0; j < 3; ++j) { if (4 * j + 3 < (p.tl & ~3)) cum += *(const LAS f32x4*)(lwp + (4 * j + 3) * 64); }
    f32x4 P, Pm1, iP;
#pragma unroll
    for (int e = 0; e < 4; ++e) { P[e] = __builtin_amdgcn_exp2f(cum[e]); Pm1[e] = __builtin_amdgcn_exp2f(cum[e] - K.lw[e]); iP[e] = __builtin_amdgcn_exp2f(-cum[e]); }
    const f32x4 at = Pm1 * K.kk, rt = P * K.r, bt = K.bb * iP, kt = K.kp * iP;
    LAS unsigned char* sb = lds + (c & 1) * S3_SET;
    const int tp = (p.tl & ~12) | ((p.tl & 4) << 1) | ((p.tl & 8) >> 1);
    const int qp = (p.q4 & ~12) | ((p.q4 & 4) << 1) | ((p.q4 & 8) >> 1);
    *(LAS v2u*)(sb + S3_AR + (p.tl * 72 + qp) * 2) = pk4(at); *(LAS v2u*)(sb + S3_AR + ((16 + p.tl) * 72 + qp) * 2) = pk4(rt);
    *(LAS v2u*)(sb + S3_BK + (p.tl * 72 + qp) * 2) = pk4(bt); *(LAS v2u*)(sb + S3_BK + ((16 + p.tl) * 72 + qp) * 2) = pk4(kt);
#pragma unroll
    for (int e = 0; e < 4; ++e) {
        *(LAS bf16*)(sb + S3_BKT + ((p.q4 + e) * 40 + tp) * 2) = f2bf(bt[e]); *(LAS bf16*)(sb + S3_BKT + ((p.q4 + e) * 40 + 16 + p.tl) * 2) = f2bf(kt[e]);
        *(LAS bf16*)(sb + S3_UVT + ((p.q4 + e) * 40 + 16 + p.tl) * 2) = f2bf(K.v[e]); }
    if (p.tl == SC2_T - 1) *(LAS f32x4*)((LAS float*)(sb + S3_PC) + p.q4) = P;
}
__device__ __forceinline__ void sc3_post(const Sc2Par& p, LAS unsigned char* lds, int c, int gi) {
    const LAS float* out = (const LAS float*)(lds + S3_OFF_OUT + (c & 1) * SC2_OUT_B) + p.tl * 64 + p.q4; const LAS float* gg = (const LAS float*)(lds + S3_OFF_GG + gi * SC2_GG_B) + p.tl * 64 + p.q4;
    const f32x4 o = *(const LAS f32x4*)(out); const float s1 = row16_sum((o[0] + o[1]) + (o[2] + o[3])), s2 = row16_sum((o[0] * o[0] + o[1] * o[1]) + (o[2] * o[2] + o[3] * o[3]));
    const float mean = s1 * (1.f / 64.f); const float rs = __builtin_amdgcn_rsqf(fmaxf(s2 * (1.f / 64.f) - mean * mean, 0.f) + 64e-5f);
    const f32x4 y = (o - mean) * rs * *(const LAS f32x4*)(gg) + *(const LAS f32x4*)(gg + SC2_VEC);
    *(v2u*)(p.MIXIN + (size_t)(p.mb + (unsigned)(c * SC2_T) + (unsigned)p.tl) * (DM * 2) + p.offP) = pk4(y);
}
__device__ __forceinline__ void scan3_stager(KA A, LAS unsigned char* lds, int sw, int lane, int l, int b, int hd) {
    Sc2Par p;
    p.P = (const unsigned char*)(A->ws + WS_P); p.LO = (const unsigned char*)(A->ws + WS_LO); p.VF = (unsigned char*)((unsigned char*)A->out + OUT_VF); p.MIXIN = (unsigned char*)(A->ws + WS_MIXIN);
    const int st = lane >> 4; p.q4 = (lane & 15) * 4; const int cc = hd * 64 + p.q4; p.tl = 4 * sw + st; p.l = l;
    const float* mu = A->in[8] + (size_t)l * 3360;
    p.mu_r = *(const f32x4*)(mu + C_R + cc); p.mu_k = *(const f32x4*)(mu + C_K + cc); p.mu_v = *(const f32x4*)(mu + C_V + cc);
    p.w0c = *(const f32x4*)(A->in[10] + l * RW + cc); p.a0c = *(const f32x4*)(A->in[12] + l * RW + cc); p.kkc = *(const f32x4*)(A->in[15] + l * RW + cc); p.kac = *(const f32x4*)(A->in[16] + l * RW + cc);
    p.rkc = *(const f32x4*)(A->in[17] + l * RW + cc); p.gnw = *(const f32x4*)(A->in[18] + l * RW + cc); p.gnb = *(const f32x4*)(A->in[19] + l * RW + cc);
    p.v0c = l > 0 ? *(const f32x4*)(A->in[20] + (l - 1) * RW + cc) : (f32x4){0.f, 0.f, 0.f, 0.f};
    p.mb = (unsigned)b * SEQ; p.offP = (unsigned)cc * 2u;
    Sc2Raw R0, R1; Sc3Keep K;
    sc2_load(R0, p, 0); sc2_load(R1, p, 1);
    sc3_phaseA(R0, p, lds, 0, 0, K); sc2_load(R0, p, 2);
    __syncthreads();
    sc3_phaseB(K, p, lds, 0);
    sc3_phaseA(R1, p, lds, 1, 1, K); sc2_load(R1, p, 3);
    __syncthreads();
#ifdef PROBE_STG2
#define SC3_DUPB(ci) if ((ci) + 1 < SC2_NC) { asm volatile("" ::: "memory"); sc3_phaseB(K, p, lds, (ci) + 1); }
#define SC3_DUPA(ci, RN) if ((ci) + 2 < SC2_NC) { asm volatile("" : "+v"(RN.pr.x), "+v"(RN.pk.x), "+v"(RN.pv.x), "+v"(RN.ld.x), "+v"(RN.la.x), "+v"(RN.lg.x), "+v"(RN.pr.y), "+v"(RN.pk.y), "+v"(RN.pv.y), "+v"(RN.ld.y), "+v"(RN.la.y), "+v"(RN.lg.y) :: "memory"); sc3_phaseA(RN, p, lds, (ci) + 2, ((ci) + 2) & 3, K); }
#else
#define SC3_DUPB(ci)
#define SC3_DUPA(ci, RN)
#endif
#define SC3_BODY(ci, RN) do { if ((ci) < SC2_NC) { if ((ci) + 1 < SC2_NC) sc3_phaseB(K, p, lds, (ci) + 1); SC3_DUPB(ci) if ((ci) + 2 < SC2_NC) sc3_phaseA(RN, p, lds, (ci) + 2, ((ci) + 2) & 3, K); SC3_DUPA(ci, RN) \
        if ((ci) + 4 < SC2_NC) sc2_load(RN, p, (ci) + 4); __syncthreads(); } } while (0)
    for (int c = 0; c < SC2_NC; c += 2) { SC3_BODY(c, R0); SC3_BODY(c + 1, R1); }
#undef SC3_BODY
}
__device__ __forceinline__ void scan3_poster(KA A, LAS unsigned char* lds, int which, int lane, int b, int hd) {
    Sc2Par p; p.MIXIN = (unsigned char*)(A->ws + WS_MIXIN); p.q4 = (lane & 15) * 4; p.mb = (unsigned)b * SEQ; p.offP = (unsigned)(hd * 64 + p.q4) * 2u;
    const int t0 = 8 * which + (lane >> 4);
    __syncthreads(); __syncthreads();
    for (int ci = 0; ci < SC2_NC; ++ci) {
        if (ci >= 1) { p.tl = t0; sc3_post(p, lds, ci - 1, (ci - 1) & 3); p.tl = t0 + 4; sc3_post(p, lds, ci - 1, (ci - 1) & 3); }
        __syncthreads();
    }
    p.tl = t0; sc3_post(p, lds, SC2_NC - 1, (SC2_NC - 1) & 3); p.tl = t0 + 4; sc3_post(p, lds, SC2_NC - 1, (SC2_NC - 1) & 3);
}
__device__ __forceinline__ void scan3_idle() {
    __syncthreads(); __syncthreads();
    for (int c = 0; c < SC2_NC; ++c) __syncthreads();
}
__device__ __forceinline__ void scan3_core(LAS unsigned char* lds, int lane0) {
    f32x16 ZT[2][2];
#pragma unroll
    for (int J = 0; J < 2; ++J)
#pragma unroll
        for (int I = 0; I < 2; ++I) ZT[J][I] = (f32x16){0.f, 0.f, 0.f, 0.f, 0.f, 0.f, 0.f, 0.f, 0.f, 0.f, 0.f, 0.f, 0.f, 0.f, 0.f, 0.f};
    for (int k = lane0; k < 2560 / 16; k += 64) ((LAS v4u*)(lds + S3_OFF_GS))[k] = (v4u){0u, 0u, 0u, 0u};
    __syncthreads(); __syncthreads();
    for (int c = 0; c < SC2_NC; ++c) {
        int lane = lane0; asm volatile("" : "+v"(lane));
        const int r = lane & 31, h = lane >> 5;
        LAS unsigned char* const sb = lds + (c & 1) * S3_SET;
        const LAS unsigned char* const pA = sb + S3_AR + (r * 72 + 8 * h) * 2;
        const LAS unsigned char* const pB = sb + S3_BK + (r * 72 + 8 * h) * 2;
        LAS float* const pLM = (LAS float*)(lds + S3_OFF_LM) + 4 * h * 36 + r;
        LAS float* const pGS = (LAS float*)(lds + S3_OFF_GS) + 4 * h * 64 + r;
        const LAS float* const LMu = (const LAS float*)(lds + S3_OFF_LM);
        const LAS float* const pGl = (const LAS float*)(lds + S3_OFF_GS) + lane;
        LAS unsigned char* const pUV = sb + S3_UVT + lane * 80;
        LAS float* const pOut = (LAS float*)(lds + S3_OFF_OUT + (c & 1) * SC2_OUT_B) + lane;
        const LAS unsigned char* const pBT = sb + S3_BKT + (r * 40 + 8 * h) * 2;
        const LAS unsigned char* const pUT = sb + S3_UVT + (r * 40 + 8 * h) * 2;
        const LAS float* const pPC = (const LAS float*)(sb + S3_PC) + 4 * h;
        const int rp = (r < 16) ? ((r & ~12) | ((r & 4) << 1) | ((r & 8) >> 1)) : r;
        LAS unsigned char* const pLMBw = lds + S3_OFF_LMB + (4 * h * 40 + rp) * 2;
        const LAS unsigned char* const pLMBa = lds + S3_OFF_LMB + (r * 40 + 8 * h) * 2;
        LAS float* const pOutD = (LAS float*)(lds + S3_OFF_OUT + (c & 1) * SC2_OUT_B) + 4 * h * 64 + r;
        const int tc = lane & 15, tcp = (tc & ~12) | ((tc & 4) << 1) | ((tc & 8) >> 1);
        LAS unsigned char* const pTw = lds + S3_OFF_GS + tcp * 2;
        const LAS unsigned char* const pTa = lds + S3_OFF_GS + (r * 40 + 8 * h) * 2;
        f32x16 acc0, acc1;
        {
            bf16x8 af[4];
            f32x16 LM = (f32x16){0.f, 0.f, 0.f, 0.f, 0.f, 0.f, 0.f, 0.f, 0.f, 0.f, 0.f, 0.f, 0.f, 0.f, 0.f, 0.f}, G0 = LM, G1 = LM;
#pragma unroll
            for (int ks = 0; ks < 4; ++ks) { af[ks] = *(const LAS bf16x8*)(pA + ks * 32); LM = __builtin_amdgcn_mfma_f32_32x32x16_bf16(af[ks], *(const LAS bf16x8*)(pB + ks * 32), LM, 0, 0, 0); }
#pragma unroll
            for (int reg = 0; reg < 16; ++reg) { const int ro = (reg & 3) + 8 * (reg >> 2);
                if (reg < 8) pLM[ro * 36] = LM[reg];
                const int tq = (reg < 8 ? ro : ro - 16) + 4 * h;
                const bool keep = (reg < 8) ? (r >= 16 && (r - 16) < tq) : ((r & 15) <= tq);
                *(LAS bf16*)(pLMBw + ro * 80) = keep ? f2bf(LM[reg]) : (bf16)0; }
#pragma unroll
            for (int ks = 0; ks < 4; ++ks) {
                const int J = ks >> 1, o8 = 8 * (ks & 1);
                v4u z0, z1;
                z0.x = cvtpk(ZT[J][0][o8 + 0], ZT[J][0][o8 + 1]); z0.y = cvtpk(ZT[J][0][o8 + 2], ZT[J][0][o8 + 3]); z0.z = cvtpk(ZT[J][0][o8 + 4], ZT[J][0][o8 + 5]); z0.w = cvtpk(ZT[J][0][o8 + 6], ZT[J][0][o8 + 7]);
                z1.x = cvtpk(ZT[J][1][o8 + 0], ZT[J][1][o8 + 1]); z1.y = cvtpk(ZT[J][1][o8 + 2], ZT[J][1][o8 + 3]); z1.z = cvtpk(ZT[J][1][o8 + 4], ZT[J][1][o8 + 5]); z1.w = cvtpk(ZT[J][1][o8 + 6], ZT[J][1][o8 + 7]);
                G0 = __builtin_amdgcn_mfma_f32_32x32x16_bf16(af[ks], __builtin_bit_cast(bf16x8, z0), G0, 0, 0, 0);
                G1 = __builtin_amdgcn_mfma_f32_32x32x16_bf16(af[ks], __builtin_bit_cast(bf16x8, z1), G1, 0, 0, 0);
            }
            LDS_WAIT(); asm volatile("" ::: "memory");
            const bf16x8 a1 = *(const LAS bf16x8*)(pLMBa + 32);
            acc0 = __builtin_amdgcn_mfma_f32_32x32x16_bf16(a1, *(const LAS bf16x8*)(pUT + 32), G0, 0, 0, 0);
            acc1 = __builtin_amdgcn_mfma_f32_32x32x16_bf16(a1, *(const LAS bf16x8*)(pUT + 32 * 80 + 32), G1, 0, 0, 0);
        }
#ifdef PROBE_CORE2
#pragma unroll 1
        for (int rep = 0; rep < 2; ++rep)
#endif
        {
            float T[16];
#pragma unroll
            for (int t = 0; t < 16; ++t) {
                float acc = (tc == t) ? 1.f : 0.f;
#pragma unroll
                for (int s4 = 0; 4 * s4 < t; ++s4) { const f32x4 la = *(const LAS f32x4*)(LMu + t * 36 + 4 * s4);
#pragma unroll
                    for (int e = 0; e < 4; ++e) if (4 * s4 + e < t) asm("v_fma_f32 %0, -%1, %2, %0" : "+v"(acc) : "v"(la[e]), "v"(T[4 * s4 + e])); }
                T[t] = acc;
                *(LAS bf16*)(pTw + t * 80) = f2bf(acc);
                if ((t & 3) == 3) asm volatile("" ::: "memory");
            }
        }
        LDS_WAIT(); asm volatile("" ::: "memory");
        bf16x8 nu0, nu1;
        {
            const bf16x8 ta = *(const LAS bf16x8*)(pTa);
            const f32x16 zero16 = (f32x16){0.f, 0.f, 0.f, 0.f, 0.f, 0.f, 0.f, 0.f, 0.f, 0.f, 0.f, 0.f, 0.f, 0.f, 0.f, 0.f};
            v4u p0, p1;
            p0.x = cvtpk(acc0[0], acc0[1]); p0.y = cvtpk(acc0[2], acc0[3]); p0.z = cvtpk(acc0[4], acc0[5]); p0.w = cvtpk(acc0[6], acc0[7]);
            p1.x = cvtpk(acc1[0], acc1[1]); p1.y = cvtpk(acc1[2], acc1[3]); p1.z = cvtpk(acc1[4], acc1[5]); p1.w = cvtpk(acc1[6], acc1[7]);
            const f32x16 u0 = __builtin_amdgcn_mfma_f32_32x32x16_bf16(ta, __builtin_bit_cast(bf16x8, p0), zero16, 0, 0, 0);
            const f32x16 u1 = __builtin_amdgcn_mfma_f32_32x32x16_bf16(ta, __builtin_bit_cast(bf16x8, p1), zero16, 0, 0, 0);
            v4u q0, q1;
            q0.x = cvtpk(-u0[0], -u0[1]); q0.y = cvtpk(-u0[2], -u0[3]); q0.z = cvtpk(-u0[4], -u0[5]); q0.w = cvtpk(-u0[6], -u0[7]);
            q1.x = cvtpk(-u1[0], -u1[1]); q1.y = cvtpk(-u1[2], -u1[3]); q1.z = cvtpk(-u1[4], -u1[5]); q1.w = cvtpk(-u1[6], -u1[7]);
            nu0 = __builtin_bit_cast(bf16x8, q0); nu1 = __builtin_bit_cast(bf16x8, q1);
        }
        {
            const bf16x8 a2 = *(const LAS bf16x8*)(pLMBa);
            acc0 = __builtin_amdgcn_mfma_f32_32x32x16_bf16(a2, nu0, acc0, 0, 0, 0);
            acc1 = __builtin_amdgcn_mfma_f32_32x32x16_bf16(a2, nu1, acc1, 0, 0, 0);
#pragma unroll
            for (int reg = 8; reg < 16; ++reg) { const int ro = (reg & 3) + 8 * (reg >> 2) - 16; pOutD[ro * 64] = acc0[reg]; pOutD[ro * 64 + 32] = acc1[reg]; }
        }
        {
            bf16x8 abk[2][2], bv[2];
#pragma unroll
            for (int X = 0; X < 2; ++X) { bv[X] = *(const LAS bf16x8*)(pUT + X * 32 * 80 + 32);
#pragma unroll
                for (int ks = 0; ks < 2; ++ks) abk[X][ks] = *(const LAS bf16x8*)(pBT + X * 32 * 80 + ks * 32); }
#pragma unroll
            for (int J = 0; J < 2; ++J) {
                ZT[J][0] = __builtin_amdgcn_mfma_f32_32x32x16_bf16(abk[J][0], nu0, ZT[J][0], 0, 0, 0); ZT[J][1] = __builtin_amdgcn_mfma_f32_32x32x16_bf16(abk[J][0], nu1, ZT[J][1], 0, 0, 0);
                ZT[J][0] = __builtin_amdgcn_mfma_f32_32x32x16_bf16(abk[J][1], bv[0], ZT[J][0], 0, 0, 0); ZT[J][1] = __builtin_amdgcn_mfma_f32_32x32x16_bf16(abk[J][1], bv[1], ZT[J][1], 0, 0, 0); }
#pragma unroll
            for (int J = 0; J < 2; ++J)
#pragma unroll
                for (int g = 0; g < 4; ++g) { const f32x4 pc = *(const LAS f32x4*)(pPC + 32 * J + 8 * g);
#pragma unroll
                    for (int I = 0; I < 2; ++I) {
#pragma unroll
                        for (int e = 0; e < 4; ++e) ZT[J][I][4 * g + e] *= pc[e]; } }
        }
        LDS_WAIT(); asm volatile("" ::: "memory");
        __syncthreads();
    }
}
#ifndef STG4
#define STG4 5
#endif
__device__ __forceinline__ void ph_scan3(KA A, const Ctx& C, int l) {
    for (int bh = blockIdx.x; bh < BATCH * 16; bh += C.G) {
        const int w = C.wave;
        if (w == 0) scan3_core(C.lds, C.lane);
        else if (w == 1 || w == 2 || w == 3 || w == STG4) scan3_stager(A, C.lds, w == STG4 ? 3 : w - 1, C.lane, l, bh >> 4, bh & 15);
        else if (w == 6 || w == 7) scan3_poster(A, C.lds, w - 6, C.lane, bh >> 4, bh & 15);
        else scan3_idle();
        __syncthreads();
    }
}
__device__ __forceinline__ void ph_scan2(KA A, const Ctx& C, int l) {
    for (int bh = blockIdx.x; bh < BATCH * 16; bh += C.G) {
        if (C.wave < 4) scan2_scanner(C.lds, C.wave, C.lane);
        else scan2_stager(A, C.lds, C.wave - 4, C.lane, l, bh >> 4, bh & 15);
        __syncthreads();
    }
}
#ifdef SCAN_SEQUENTIAL
#define SCAN_IMPL ph_scan2
#else
#define SCAN_IMPL ph_scan3
#endif
#ifdef ATTN_TWO_PASS
#define ATT_IMPL ph_attn
#else
#define ATT_IMPL ph_attn2
#endif
__device__ __forceinline__ void ph_mixer(KA A, const Ctx& C, int l) {
#ifdef PROBE_ATTN_FIRST
    ATT_IMPL(A, C, l, (unsigned*)(A->ws + WS_CTL) + CW_Q + 64 * l);
    __syncthreads();
#ifdef PROBE_ATTN_REP
    ATT_IMPL(A, C, l, (unsigned*)(A->ws + WS_CTL) + CW_Q + 64 * l + 32);
    __syncthreads();
#endif
    SCAN_IMPL(A, C, l);
#else
    SCAN_IMPL(A, C, l);
#ifdef PROBE_SCAN_REP
    SCAN_IMPL(A, C, l);
#endif
    Ctx C2 = C; asm volatile("v_mbcnt_lo_u32_b32 %0, -1, 0\n\tv_mbcnt_hi_u32_b32 %0, -1, %0" : "=v"(C2.lane)); C2.tid = C2.wave * 64 + C2.lane;
    KA A2 = A; asm volatile("" : "+s"(A2));
    ATT_IMPL(A2, C2, l, (unsigned*)(A2->ws + WS_CTL) + CW_Q + 64 * l);
#endif
}
__global__ void __launch_bounds__(NWAVES * 64, 2) fwd_kernel(Args KARG) {
    extern __shared__ __attribute__((aligned(16))) unsigned char lds_raw[];
    Ctx C0;
    C0.lds = (LAS unsigned char*)lds_raw;
    C0.tid = 0; C0.lane = 0; C0.wave = __builtin_amdgcn_readfirstlane((int)threadIdx.x >> 6);
    C0.G = gridDim.x; { const int bx = blockIdx.x; C0.vcu = (C0.G % 8 == 0) ? (bx % 8) * (C0.G / 8) + bx / 8 : bx; }
    C0.gw = C0.vcu * NWAVES + C0.wave; C0.NGW = C0.G * NWAVES;
    for (int u = threadIdx.x; u < (LDS_BYTES - LDSCTL_OFF) / 4; u += NWAVES * 64) ((LAS unsigned*)(C0.lds + LDSCTL_OFF))[u] = 0u;
    __syncthreads();
    volatile LAS unsigned* MISC = (volatile LAS unsigned*)(C0.lds + MISC_OFF);
    unsigned* barw = (unsigned*)(KARG.ws + WS_CTL) + CW_BAR + KARG.li * XCD_BAR_WORDS;
    XcdBarrier bar; bar.bar = barw; bar.x = 0; bar.st = nullptr;
    const int lo = KARG.ph_lo, hi = KARG.ph_hi;
    if (hi - lo > 1) bar = xcd_barrier_post(barw, MISC + 8);
#ifdef NAIVE_ATTN
#define ATTN_CALL ph_attn_naive
#else
#define ATTN_CALL(A_, C_, l_) ph_attn(A_, C_, l_, (unsigned*)((A_)->ws + WS_CTL) + CW_Q + 64 * (l_))
#endif
#ifdef NAIVE_SCAN
#define SCAN_CALL ph_scan_naive
#else
#define SCAN_CALL ph_scan
#endif
#ifdef NAIVE_LORA
#define LORA_CALL ph_lora_naive(A, C, l);
#else
#define LORA_CALL pg8::Gemm g{(const bf16*)(ws + WS_LA), (const bf16*)(ws + WS_WL), M, LON, LAK}; pg8::StaticOrder S; S.init(M, LON, C.G, (int)blockIdx.x, 2, 4, 1); pg8::EpiBf16<0, true> E{(bf16*)(ws + WS_LO), LON, nullptr, 0, 0, 1.f};                  pg8::gemm_phase<pg8::EpiBf16<0, true>, pg8::StaticOrder, true, true>(C.lds, g, S, E, C.tid);
#endif
#if defined(NAIVE_ATTN) || defined(NAIVE_SCAN)
#define MIXER_CALL ATTN_CALL(A, C, l); __syncthreads(); SCAN_CALL(A, C, l);
#else
#define MIXER_CALL ph_mixer(A, C, l);
#endif
#ifndef WGM_IN
#define WGM_IN 4
#endif
#ifndef WGM_LORA
#define WGM_LORA 4
#endif
#ifndef WGM_UP
#define WGM_UP 4
#endif
#ifndef WGM_OUT
#define WGM_OUT 4
#endif
#ifndef WGM_DOWN
#define WGM_DOWN 4
#endif
#ifndef PH_REP
#define PH_REP 0
#endif
#ifndef PH_MASK
#define PH_MASK 0x7ff
#endif
#define PHASE(k, ...) do { constexpr int pid = l * 11 + (k); if constexpr (!((k) == 0 && l > 0)) if (pid >= lo && pid < hi) { Ctx C = C0; asm volatile("v_mbcnt_lo_u32_b32 %0, -1, 0\n\tv_mbcnt_hi_u32_b32 %0, -1, %0" : "=v"(C.lane)); C.tid = C.wave * 64 + C.lane; \
        if constexpr ((PH_MASK >> (k)) & 1) { KA A = (KA)__builtin_amdgcn_kernarg_segment_ptr(); asm volatile("" : "+s"(A)); unsigned char* ws = A->ws; bf16* H = (bf16*)((unsigned char*)A->out + OUT_H); bf16* XB = (bf16*)(ws + WS_XB); __VA_ARGS__; \
            if constexpr ((PH_REP >> (k)) & 1) { __syncthreads(); __VA_ARGS__; } } \
        if (pid + 1 < hi) xcd_barrier(bar, C.tid); } } while (0)
#define LAYER_BODY \
        PHASE(0, { ph_wconv(A, C, 0); ph_prologue(A, C); });        \
        PHASE(1, { pg8::Gemm g{H, (const bf16*)(ws + WS_WIN), M, PP, DM}; pg8::StaticOrder S; S.init(M, PP, C.G, (int)blockIdx.x, WGM_IN); pg8::EpiBf16<0, true> E{(bf16*)(ws + WS_P), PP, nullptr, 0, 0, 1.f}; \
                pg8::gemm_phase<pg8::EpiBf16<0, true>, pg8::StaticOrder, true, true>(C.lds, g, S, E, C.tid); }); \
        PHASE(2, { ph_e0(A, C, l); }); \
        PHASE(3, { LORA_CALL }); \
        PHASE(4, { MIXER_CALL }); \
        PHASE(5, { pg8::Gemm g{(const bf16*)(ws + WS_MIXIN), (const bf16*)(ws + WS_WOUT), M, DM, DM}; pg8::StaticOrder S; S.init(M, DM, C.G, (int)blockIdx.x, WGM_OUT); pg8::EpiBf16<0> E{(bf16*)(ws + WS_MIX), DM, nullptr, 0, 0, 1.f}; \
                pg8::gemm_phase<pg8::EpiBf16<0>, pg8::StaticOrder, true, true>(C.lds, g, S, E, C.tid); }); \
        PHASE(6, { ph_res(C, (const bf16*)(ws + WS_MIX), l == 0 ? A->in[0] : nullptr, XB, XB, nullptr, A->in[3] + (size_t)l * DM, A->in[4] + (size_t)l * DM, H); }); \
        PHASE(7, { pg8::Gemm g{H, (const bf16*)(ws + WS_WUP), M, 2 * DFF, DM}; pg8::StaticOrder S; S.init(M, 2 * DFF, C.G, (int)blockIdx.x, WGM_UP); \
                EpiAct E{(bf16*)(ws + WS_ACT), A->in[29] + (size_t)l * 3 * DFF, A->in[30] + (size_t)l * DFF, (bf16*)(ws + WS_GL), (bf16*)(ws + WS_R01), (LAS float*)(C.lds + BND_OFF)}; \
                pg8::gemm_phase<EpiAct, pg8::StaticOrder, true, true>(C.lds, g, S, E, C.tid); }); \
        PHASE(8, { ph_actfix(A, C, l); }); \
        PHASE(9, { pg8::Gemm g{(const bf16*)(ws + WS_ACT), (const bf16*)(ws + WS_WDN), M, DM, DFF}; pg8::StaticOrder S; S.init(M, DM, C.G, (int)blockIdx.x, WGM_DOWN); pg8::EpiBf16<0> E{(bf16*)(ws + WS_FF), DM, nullptr, 0, 0, 1.f}; \
                pg8::gemm_phase<pg8::EpiBf16<0>, pg8::StaticOrder, true, true>(C.lds, g, S, E, C.tid); }); \
        PHASE(10, { ph_res(C, (const bf16*)(ws + WS_FF), nullptr, XB, l + 1 < DEPTH ? XB : nullptr, l + 1 < DEPTH ? nullptr : A->out, A->in[5] + (size_t)l * DM, l + 1 < DEPTH ? A->in[2] + (size_t)(l + 1) * DM : nullptr, H); if constexpr (l + 1 < DEPTH) ph_wconv(A, C, l + 1); }); \

    { constexpr int l = 0; LAYER_BODY }
    { constexpr int l = 1; LAYER_BODY }
    { constexpr int l = 2; LAYER_BODY }
    { constexpr int l = 3; LAYER_BODY }
#undef LAYER_BODY
#undef PHASE
}

extern "C" void kernel_launch(void* const* d_in, const int* in_sizes, int n_in, void* d_out, int out_size, void* d_ws, size_t ws_size, hipStream_t stream) {
    static int grid = 0;
    if (grid == 0) {
        if (n_in != 32 || in_sizes[0] != M * DM || out_size != M * DM || ws_size < WS_END) { fprintf(stderr, "kernel_launch: unexpected problem (n_in %d, out %d, ws %zu < %zu)\n", n_in, out_size, ws_size, (size_t)WS_END); grid = -1; return; }
        int dev = 0, cus = 0, per_cu = 0;
        if (hipGetDevice(&dev) != hipSuccess || hipDeviceGetAttribute(&cus, hipDeviceAttributeMultiprocessorCount, dev) != hipSuccess) { grid = -1; return; }
        if (hipFuncSetAttribute((const void*)fwd_kernel, hipFuncAttributeMaxDynamicSharedMemorySize, LDS_BYTES) != hipSuccess) { fprintf(stderr, "kernel_launch: hipFuncSetAttribute failed\n"); grid = -1; return; }
        if (hipOccupancyMaxActiveBlocksPerMultiprocessor(&per_cu, (const void*)fwd_kernel, NWAVES * 64, LDS_BYTES) != hipSuccess || per_cu < 1) fprintf(stderr, "kernel_launch: occupancy query reports %d\n", per_cu);
        (void)hipGetLastError();
        grid = cus;
    }
    if (grid < 0) return;
    if (hipMemsetAsync((char*)d_ws + WS_CTL, 0, CTL_ZERO_BYTES, stream) != hipSuccess) return;
    Args a{};
    for (int i = 0; i < 32; ++i) a.in[i] = (const float*)d_in[i];
    a.out = (float*)d_out; a.ws = (unsigned char*)d_ws;
#if MK_SINGLE
    a.ph_lo = 0; a.ph_hi = NPHASE; a.li = 0;
    hipLaunchKernelGGL(fwd_kernel, dim3(grid), dim3(NWAVES * 64), LDS_BYTES, stream, a);
#else
    for (int p = 0; p < NPHASE; ++p) { a.ph_lo = p; a.ph_hi = p + 1; a.li = 0; hipLaunchKernelGGL(fwd_kernel, dim3(grid), dim3(NWAVES * 64), LDS_BYTES, stream, a); }
#endif
}
```

```cpp
#include <hip/hip_runtime.h>
#include <cstdio>
#include <cstdint>
#include <cmath>
namespace pg8 {
#define PG8_LAS __attribute__((address_space(3)))
typedef unsigned short bf16_t;
typedef short bf16x8 __attribute__((ext_vector_type(8)));
typedef float f32x4 __attribute__((ext_vector_type(4)));
typedef unsigned u32x4 __attribute__((ext_vector_type(4)));
constexpr int BM = 256, BK = 64, HALF = 128, HTB = HALF * BK * 2  , STAGE_BYTES = 8 * HTB, NXCD = 8, WGM = 4;

__host__ __device__ __forceinline__ int lds_byte(int r, int c) { const int st = (r >> 4) * 2 + (c >> 5), rr = r & 15, cc = c & 31, ob = rr * 64 + cc * 2; return st * 1024 + (ob ^ (((ob >> 9) & 1) << 5)); }
__host__ __device__ __forceinline__ void stage_rc(int b, int& R, int& C) { const int st = b / 1024, sb = b % 1024, swz = sb ^ (((sb >> 9) & 1) << 5); R = (st >> 1) * 16 + swz / 64; C = (st & 1) * 32 + (swz % 64) / 2; }
__host__ __device__ __forceinline__ int perm32(int rho) { const int n = rho >> 4, i = rho & 15; return 8 * (i >> 2) + 4 * n + (i & 3); }

struct Unit { int pm, pn; };
struct Gemm { const bf16_t* A; const bf16_t* Bt; int M, N, K; };

struct StaticOrder {
    int nM, nN, nwg, G, c, wgm, rot, kmode;
    int pad_;
    __host__ __device__ void init(int M, int N, int G_, int c_, int wgm_ = WGM, int rot_ = 0, int kmode_ = 0) { nM = M / BM; nN = N / BM; nwg = nM * nN; G = G_; c = c_; wgm = wgm_; rot = rot_; kmode = kmode_; pad_ = 0; }
    __host__ __device__ bool next(int i, Unit& u) const {
        const long L = (long)i * G + c; if (L >= nwg) return false;
        int wgid = (int)L; { const int q = nwg / NXCD, r = nwg % NXCD, xcd = wgid % NXCD, off = wgid / NXCD; wgid = (xcd < r ? xcd * (q + 1) : r * (q + 1) + (xcd - r) * q) + off; }
        const int nig = wgm * nN, gid = wgid / nig, fm = gid * wgm, gsz = (nM - fm) < wgm ? (nM - fm) : wgm;
        u.pm = fm + ((wgid % nig) % gsz); u.pn = (wgid % nig) / gsz; if (rot) u.pn = (u.pn + rot * i) % nN; return true;
    }
    __device__ __forceinline__ void a_ready(const Unit&) const {}
    __device__ __forceinline__ void done(const Unit&) const {}
    __device__ __forceinline__ void krange(const Unit& u, int nt_full, int& k0, int& ntu) const {
        if (kmode == 1) { const int blk = u.pn >> 2; k0 = (blk == 2) ? 2 : (blk == 3) ? 4 : 0; ntu = (blk == 2) ? 4 : 2; } else { k0 = 0; ntu = nt_full; } }
};

__device__ __forceinline__ unsigned cvt_pk_bf16(float lo, float hi) { unsigned r; asm volatile("v_cvt_pk_bf16_f32 %0, %1, %2" : "=v"(r) : "v"(lo), "v"(hi)); return r; }
typedef float f32x2 __attribute__((ext_vector_type(2)));
__device__ __forceinline__ f32x2 gelu_pk(f32x2 v) {
    const f32x2 av = __builtin_elementwise_abs(v), d = av * 0.2316418882f + 1.0f;
    f32x2 t; t.x = __builtin_amdgcn_rcpf(d.x); t.y = __builtin_amdgcn_rcpf(d.y);
    f32x2 q = t * 0.5307027145f + (-0.7265760135f); q = q * t + 0.7107068705f; q = q * t + (-0.142248368f); q = q * t + 0.127414796f; q = q * t;
    const f32x2 s = (v * v) * (-0.72134752044f);
    f32x2 e; e.x = __builtin_amdgcn_exp2f(s.x); e.y = __builtin_amdgcn_exp2f(s.y);
    const f32x2 m = v * (q * e), r = v - m;
    f32x2 o; o.x = v.x < 0.f ? m.x : r.x; o.y = v.y < 0.f ? m.y : r.y; return o;
}

template <int ACT  , bool NT = false  > struct EpiBf16 {
    static constexpr bool PERM = true, AFTER_DRAIN = false; static_assert(ACT == 0 || ACT == 1, "EpiBf16: ACT is 0 (none) or 1 (gelu_pk)");
    bf16_t* O; int ldc; const float* bias; int split_cols; size_t split_stride; float scale0;
    __device__ __forceinline__ void operator()(const f32x4 (&acc)[2][2][4][2], const Unit& u, int wr, int wc, int fr, int fq) const {
        const int row0 = u.pm * BM + wr * 64 + fr; int colt = u.pn * BM; bf16_t* base = O;
        float sc = 1.f; if (split_cols) { const int t = colt / split_cols; base += (size_t)t * split_stride; colt -= t * split_cols; if (t == 0) sc = scale0; }
        const int col0 = colt + wc * 32 + 8 * fq, bcol0 = u.pn * BM + wc * 32 + 8 * fq;
        f32x4 bv[2][2];
#pragma unroll
        for (int bj = 0; bj < 2; ++bj)
#pragma unroll
            for (int n = 0; n < 2; ++n) bv[bj][n] = bias ? *(const f32x4*)(bias + bcol0 + bj * HALF + 4 * n) : (f32x4){0.f, 0.f, 0.f, 0.f};
#pragma unroll
        for (int ai = 0; ai < 2; ++ai)
#pragma unroll
            for (int m = 0; m < 4; ++m) { bf16_t* rowp = base + (size_t)(row0 + ai * HALF + m * 16) * ldc + col0;
#pragma unroll
                for (int bj = 0; bj < 2; ++bj) { f32x4 v0 = acc[ai][bj][m][0] + bv[bj][0], v1 = acc[ai][bj][m][1] + bv[bj][1];
                    if (ACT == 1) { f32x2 a = gelu_pk((f32x2){v0[0], v0[1]}), b = gelu_pk((f32x2){v0[2], v0[3]}), c = gelu_pk((f32x2){v1[0], v1[1]}), d = gelu_pk((f32x2){v1[2], v1[3]});
                        v0 = (f32x4){a.x, a.y, b.x, b.y}; v1 = (f32x4){c.x, c.y, d.x, d.y}; }
                    v0 = v0 * sc; v1 = v1 * sc; u32x4 w; w.x = cvt_pk_bf16(v0[0], v0[1]); w.y = cvt_pk_bf16(v0[2], v0[3]); w.z = cvt_pk_bf16(v1[0], v1[1]); w.w = cvt_pk_bf16(v1[2], v1[3]);
                    if (NT) __builtin_nontemporal_store(w, (u32x4*)(rowp + bj * HALF)); else *(u32x4*)(rowp + bj * HALF) = w; } }
    }
};
template <class Epi, class Sched, bool ALIGN_EPI = false, bool SP2 = false>
__device__ __forceinline__ void gemm_phase(PG8_LAS unsigned char* lds, const Gemm g, const Sched& S, const Epi& E, int tid_in  ) {
    int tid_ = tid_in; asm volatile("" : "+v"(tid_));
    const int tid = tid_, wid = __builtin_amdgcn_readfirstlane(tid >> 6), lane = tid & 63, wr = wid >> 2, wc = wid & 3, fr = lane & 15, fq = lane >> 4;
    int K_ = g.K; asm volatile("" : "+s"(K_));
    const int K = K_, nt = K / BK;
    unsigned voffA[2], voffB[2];
#pragma unroll
    for (int i = 0; i < 2; ++i) { int R, C; stage_rc(tid * 16 + i * 8192, R, C); const int Rb = Epi::PERM ? ((R & ~31) + perm32(R & 31)) : R;
        voffA[i] = (unsigned)(R * K + C) * 2u; voffB[i] = (unsigned)(Rb * K + C) * 2u; }
    const size_t kstep = (size_t)(BK * 2);
    const size_t hstep = (size_t)HALF * K * 2;
    const size_t tstep = 2 * hstep;
    const unsigned ldsw = (unsigned)wid * 1024u;
    const int aoff = lds_byte(wr * 64 + fr, fq * 8), boff = lds_byte(wc * 32 + fr, fq * 8);
#define PG8_SA(b, h) (((b) * 2 + (h)) * HTB)
#define PG8_SB(b, h) ((4 + (b) * 2 + (h)) * HTB)
#define PG8_STAGE(bufoff, gbase, voff) do { _Pragma("unroll") for (int _i = 0; _i < 2; ++_i) \
        __builtin_amdgcn_global_load_lds((const unsigned*)((const char*)(gbase) + (voff)[_i]), (PG8_LAS unsigned*)(lds + (bufoff) + ldsw + _i * 8192), 16, 0, 0); } while (0)
#define PG8_LDA(dst, b, h) do { _Pragma("unroll") for (int m = 0; m < 4; ++m) _Pragma("unroll") for (int k = 0; k < 2; ++k) dst[m][k] = *(const PG8_LAS bf16x8*)(lds + PG8_SA(b, h) + aoff + m * 2048 + k * 1024); } while (0)
#define PG8_LDB(dst, b, h) do { _Pragma("unroll") for (int n = 0; n < 2; ++n) _Pragma("unroll") for (int k = 0; k < 2; ++k) dst[n][k] = *(const PG8_LAS bf16x8*)(lds + PG8_SB(b, h) + boff + n * 2048 + k * 1024); } while (0)
#define PG8_MMA(ai, bj, At, Bt) do { __builtin_amdgcn_s_setprio(1); _Pragma("unroll") for (int m = 0; m < 4; ++m) _Pragma("unroll") for (int n = 0; n < 2; ++n) _Pragma("unroll") for (int k = 0; k < 2; ++k) \
        acc[ai][bj][m][n] = __builtin_amdgcn_mfma_f32_16x16x32_bf16(Bt[n][k], At[m][k], acc[ai][bj][m][n], 0, 0, 0); __builtin_amdgcn_s_setprio(0); } while (0)
#define PG8_WAIT_V(n) asm volatile("s_waitcnt vmcnt(" #n ")" ::: "memory")
#define PG8_WAIT_L(n) asm volatile("s_waitcnt lgkmcnt(" #n ")" ::: "memory")
#define PG8_BAR __builtin_amdgcn_s_barrier()
#define PG8_SCHED __builtin_amdgcn_sched_barrier(0)
    Unit cur, nxt; int ui = 0;
    if (!S.next(0, cur)) return;
    f32x4 acc[2][2][4][2];
#pragma unroll
    for (int a = 0; a < 2; ++a)
#pragma unroll
        for (int b = 0; b < 2; ++b)
#pragma unroll
            for (int m = 0; m < 4; ++m)
#pragma unroll
                for (int n = 0; n < 2; ++n) acc[a][b][m][n] = (f32x4){0.f, 0.f, 0.f, 0.f};
    bf16x8 At[4][2], B0[2][2], B1[2][2];
    int k0c, ntc; S.krange(cur, nt, k0c, ntc);
    const char* cA = (const char*)g.A + (size_t)cur.pm * tstep + (size_t)k0c * kstep; const char* cB = (const char*)g.Bt + (size_t)cur.pn * tstep + (size_t)k0c * kstep;
    S.a_ready(cur);
    if constexpr (SP2) {
        PG8_STAGE(PG8_SB(0, 0), cB, voffB); PG8_STAGE(PG8_SB(0, 1), cB + hstep, voffB); PG8_STAGE(PG8_SA(0, 0), cA, voffA); PG8_STAGE(PG8_SA(0, 1), cA + hstep, voffA);
        if (wr == 1) PG8_BAR;
        PG8_WAIT_V(2); PG8_BAR;
        PG8_STAGE(PG8_SB(1, 0), cB + kstep, voffB); PG8_STAGE(PG8_SA(1, 0), cA + kstep, voffA); PG8_STAGE(PG8_SB(1, 1), cB + hstep + kstep, voffB);
        PG8_WAIT_V(6); PG8_BAR;
    } else {
        PG8_STAGE(PG8_SB(0, 0), cB, voffB); PG8_STAGE(PG8_SA(0, 0), cA, voffA); PG8_STAGE(PG8_SB(0, 1), cB + hstep, voffB); PG8_STAGE(PG8_SA(0, 1), cA + hstep, voffA);
        if (wr == 1) PG8_BAR;
        PG8_WAIT_V(4); PG8_BAR;
        PG8_STAGE(PG8_SB(1, 0), cB + kstep, voffB); PG8_STAGE(PG8_SA(1, 0), cA + kstep, voffA); PG8_STAGE(PG8_SB(1, 1), cB + hstep + kstep, voffB);
        PG8_WAIT_V(6); PG8_BAR;
    }
    for (;;) {
        const bool has_next = S.next(ui + 1, nxt);
        int k0n = 0, ntn = nt; if (has_next) S.krange(nxt, nt, k0n, ntn);
        const char* nA = has_next ? (const char*)g.A + (size_t)nxt.pm * tstep + (size_t)k0n * kstep : cA; const char* nB = has_next ? (const char*)g.Bt + (size_t)nxt.pn * tstep + (size_t)k0n * kstep : cB;
        for (int t = 0; t < ntc; t += 2) {
            const bool last = (t == ntc - 2);
            const char* a1 = cA + (size_t)(t + 1) * kstep;
            const char* a2 = last ? nA : cA + (size_t)(t + 2) * kstep; const char* b2 = last ? nB : cB + (size_t)(t + 2) * kstep;
            const char* a3 = a2 + kstep; const char* b3 = b2 + kstep;
            if (last && has_next) S.a_ready(nxt);
            if constexpr (SP2) {
            PG8_LDB(B0, 0, 0); PG8_LDB(B1, 0, 1); PG8_SCHED; PG8_LDA(At, 0, 0); PG8_STAGE(PG8_SA(1, 1), a1 + hstep, voffA);
            PG8_WAIT_V(8); PG8_WAIT_L(0); PG8_BAR; PG8_MMA(0, 0, At, B0); PG8_MMA(0, 1, At, B1); PG8_BAR; PG8_SCHED;
            PG8_LDA(At, 0, 1); PG8_STAGE(PG8_SB(0, 0), b2, voffB); PG8_STAGE(PG8_SB(0, 1), b2 + hstep, voffB); PG8_STAGE(PG8_SA(0, 0), a2, voffA);
            PG8_WAIT_V(8); PG8_WAIT_L(0); PG8_BAR; PG8_MMA(1, 0, At, B0); PG8_MMA(1, 1, At, B1); PG8_BAR; PG8_SCHED;
            PG8_LDB(B0, 1, 0); PG8_LDB(B1, 1, 1); PG8_SCHED; PG8_LDA(At, 1, 0); PG8_STAGE(PG8_SA(0, 1), a2 + hstep, voffA);
            PG8_WAIT_V(8); PG8_WAIT_L(0); PG8_BAR; PG8_MMA(0, 0, At, B0); PG8_MMA(0, 1, At, B1); PG8_BAR; PG8_SCHED;
            PG8_LDA(At, 1, 1); PG8_STAGE(PG8_SB(1, 0), b3, voffB); PG8_STAGE(PG8_SB(1, 1), b3 + hstep, voffB); PG8_STAGE(PG8_SA(1, 0), a3, voffA);
            PG8_WAIT_V(8); PG8_WAIT_L(0); PG8_BAR; PG8_MMA(1, 0, At, B0); PG8_MMA(1, 1, At, B1); PG8_BAR; PG8_SCHED;
            } else {
            PG8_LDB(B0, 0, 0); PG8_SCHED; PG8_LDA(At, 0, 0); PG8_STAGE(PG8_SA(1, 1), a1 + hstep, voffA);
            PG8_WAIT_L(8); PG8_BAR; PG8_WAIT_L(0); PG8_MMA(0, 0, At, B0); PG8_BAR; PG8_SCHED;
            PG8_LDB(B1, 0, 1); PG8_STAGE(PG8_SB(0, 0), b2, voffB);
            PG8_BAR; PG8_WAIT_L(0); PG8_MMA(0, 1, At, B1); PG8_BAR;
            PG8_LDA(At, 0, 1); PG8_STAGE(PG8_SA(0, 0), a2, voffA);
            PG8_BAR; PG8_WAIT_L(0); PG8_MMA(1, 0, At, B0); PG8_BAR; PG8_SCHED;
            PG8_STAGE(PG8_SB(0, 1), b2 + hstep, voffB);
            PG8_WAIT_V(6); PG8_BAR; PG8_MMA(1, 1, At, B1); PG8_BAR;
            PG8_LDB(B0, 1, 0); PG8_SCHED; PG8_LDA(At, 1, 0); PG8_STAGE(PG8_SA(0, 1), a2 + hstep, voffA);
            PG8_WAIT_L(8); PG8_BAR; PG8_WAIT_L(0); PG8_MMA(0, 0, At, B0); PG8_BAR; PG8_SCHED;
            PG8_LDB(B1, 1, 1); PG8_STAGE(PG8_SB(1, 0), b3, voffB);
            PG8_BAR; PG8_WAIT_L(0); PG8_MMA(0, 1, At, B1); PG8_BAR;
            PG8_LDA(At, 1, 1); PG8_STAGE(PG8_SA(1, 0), a3, voffA);
            PG8_BAR; PG8_WAIT_L(0); PG8_MMA(1, 0, At, B0); PG8_BAR; PG8_SCHED;
            PG8_STAGE(PG8_SB(1, 1), b3 + hstep, voffB);
            PG8_WAIT_V(6); PG8_BAR; PG8_MMA(1, 1, At, B1); PG8_BAR;
            }
        }
        if constexpr (ALIGN_EPI) { if (wr == 0) PG8_BAR; }
        if constexpr (!Epi::AFTER_DRAIN) { E(acc, cur, wr, wc, fr, fq); S.done(cur); }
        if (!has_next) break;
#pragma unroll
        for (int a = 0; a < 2; ++a)
#pragma unroll
            for (int b = 0; b < 2; ++b)
#pragma unroll
                for (int m = 0; m < 4; ++m)
#pragma unroll
                    for (int n = 0; n < 2; ++n) acc[a][b][m][n] = (f32x4){0.f, 0.f, 0.f, 0.f};
        cur = nxt; cA = nA; cB = nB; ntc = ntn; ++ui;
        if constexpr (ALIGN_EPI) { if (wr == 1) PG8_BAR; }
    }
    PG8_WAIT_V(0);
    if constexpr (!ALIGN_EPI) { if (wr == 0) PG8_BAR; }
    PG8_BAR;
    if constexpr (Epi::AFTER_DRAIN) { E.fused(acc, cur, wr, wc, fr, fq, lds, wid, lane); S.done(cur); }
#undef PG8_SA
#undef PG8_SB
#undef PG8_STAGE
#undef PG8_LDA
#undef PG8_LDB
#undef PG8_MMA
#undef PG8_WAIT_V
#undef PG8_WAIT_L
#undef PG8_BAR
#undef PG8_SCHED
}
}
#define LAS __attribute__((address_space(3)))
#define XB_TMO      128
#define XB_XCNT(j)  (256  + 64 * (j))
#define XB_XSUB(j)  (1280 + 64 * (j))
#define XB_XGEN(j)  (2304 + 64 * (j))
#define XB_TOP      3328
#define XB_TOPGEN   3392
#define XCD_BAR_WORDS 3456
#define XB_SPIN_CAP (1u << 23)

__device__ __forceinline__ unsigned xb_ld(unsigned* p)              { return __hip_atomic_load(p, __ATOMIC_RELAXED, __HIP_MEMORY_SCOPE_AGENT); }
__device__ __forceinline__ unsigned xb_add(unsigned* p, unsigned v) { return __hip_atomic_fetch_add(p, v, __ATOMIC_RELAXED, __HIP_MEMORY_SCOPE_AGENT); }
__device__ __forceinline__ unsigned xb_xcc_id() { return (unsigned)__builtin_amdgcn_s_getreg((3 << 11) | 20) & 0xFu; }
#define XB_SPIN(cond, bar) do { unsigned _sp = 0; while (cond) { __builtin_amdgcn_s_sleep(1); \
    if ((++_sp & 255u) == 0u) { if (xb_ld(&(bar)[XB_TMO])) break; if (_sp > XB_SPIN_CAP) { atomicAdd(&(bar)[XB_TMO], 1u); break; } } } } while (0)

struct XcdBarrier {
    unsigned* bar; unsigned x;
    volatile LAS unsigned* st;
};

__device__ __forceinline__ XcdBarrier xcd_barrier_post(unsigned* bar, volatile LAS unsigned* st) {
    XcdBarrier b; b.bar = bar; b.x = xb_xcc_id(); b.st = st;
    if (threadIdx.x == 0) (void)xb_add(&bar[XB_XCNT(b.x)], 1u);
    return b;
}
__device__ __forceinline__ void xcd_barrier_complete(unsigned* bar, unsigned x, unsigned& nloc, unsigned& nx) {
    const unsigned G = gridDim.x * gridDim.y * gridDim.z;
    unsigned sum, cnt, mine, sp = 0u;
    for (;;) {
        sum = 0u; cnt = 0u; mine = 0u;
#pragma unroll
        for (unsigned j = 0; j < 16; ++j) { const unsigned c = xb_ld(&bar[XB_XCNT(j)]); sum += c; cnt += (c > 0u) ? 1u : 0u; mine = (j == x) ? c : mine; }
        if (sum == G) break;
        __builtin_amdgcn_s_sleep(1);
        if ((++sp & 255u) == 0u) { if (xb_ld(&bar[XB_TMO])) break; if (sp > XB_SPIN_CAP) { atomicAdd(&bar[XB_TMO], 1u); break; } }
    }
    nloc = mine > 0u ? mine : 1u; nx = cnt > 0u ? cnt : 1u;
}

__device__ __forceinline__ void xcd_barrier(const XcdBarrier& b, const int tid_x  ) {
    asm volatile("s_waitcnt vmcnt(0)" ::: "memory");
    __syncthreads();
    if (tid_x == 0) {
        unsigned* bar = b.bar;
        __builtin_amdgcn_s_waitcnt(0);
        unsigned nloc = b.st[0], nx = b.st[1];
        if (nloc == 0u) { xcd_barrier_complete(bar, b.x, nloc, nx); b.st[0] = nloc; b.st[1] = nx; }
        const unsigned old = xb_add(&bar[XB_XSUB(b.x)], 1u);
        const unsigned gen = old / nloc;
        if (old + 1u == (gen + 1u) * nloc) {
            __builtin_amdgcn_fence(__ATOMIC_RELEASE, "agent");
            asm volatile("s_waitcnt vmcnt(0)" ::: "memory");
            const unsigned og = xb_add(&bar[XB_TOP], 1u);
            const unsigned tg = og / nx;
            if (og + 1u == (tg + 1u) * nx) xb_add(&bar[XB_TOPGEN], 1u);
            else XB_SPIN(xb_ld(&bar[XB_TOPGEN]) == tg, bar);
            __builtin_amdgcn_fence(__ATOMIC_ACQUIRE, "agent");
            xb_add(&bar[XB_XGEN(b.x)], 1u);
            asm volatile("s_waitcnt vmcnt(0)" ::: "memory");
        } else {
            XB_SPIN(xb_ld(&bar[XB_XGEN(b.x)]) == gen, bar);
            __builtin_amdgcn_fence(__ATOMIC_ACQUIRE, "agent");
            asm volatile("s_waitcnt vmcnt(0)" ::: "memory");
        }
    }
    __syncthreads();
}

#ifndef MK_SINGLE
#define MK_SINGLE 1
#endif
#define GAS __attribute__((address_space(1)))
typedef unsigned short bf16;
typedef unsigned v4u __attribute__((ext_vector_type(4)));
typedef unsigned v2u __attribute__((ext_vector_type(2)));
typedef float f32x4 __attribute__((ext_vector_type(4)));
typedef float f32x16 __attribute__((ext_vector_type(16)));
typedef short bf16x8 __attribute__((ext_vector_type(8)));
typedef float f32x2_t __attribute__((ext_vector_type(2)));
typedef __bf16 bf16x2_t __attribute__((ext_vector_type(2)));

constexpr int NWAVES = 8;
constexpr int BATCH = 8, SEQ = 4096, DM = 2048, DEPTH = 4, M = BATCH * SEQ;
constexpr int RW = 1024, DFF = 5632, IN_COLS = 6432, PP = 6656  , LAK = 384, LON = 4096;
constexpr int C_R = 0, C_WL = 1024, C_K = 1088, C_V = 2112, C_AL = 3136, C_GL = 3200, C_Q = 3360, C_KD = 4384, C_VD = 5408, C_MV = 6432;
constexpr float QSCALE = 0.125f * 1.4426950408889634f;
constexpr int NPHASE = 11 * DEPTH;

constexpr size_t MiB = 1u << 20;
constexpr size_t WS_CTL = 0, CTL_ZERO_BYTES = 1 * MiB;
constexpr size_t WS_CS = 1 * MiB;
constexpr size_t WS_WIN = 4 * MiB, WS_WL = 30 * MiB, WS_WOUT = 33 * MiB, WS_WUP = 41 * MiB, WS_WDN = 85 * MiB;
constexpr size_t WS_XB = 108 * MiB;
constexpr size_t OUT_H = 0, OUT_VF = 128 * MiB;
constexpr size_t WS_H = WS_XB;
constexpr size_t WS_VF = 236 * MiB;
constexpr size_t WS_R = 300 * MiB;
constexpr size_t WS_P = WS_R, WS_LA = WS_R + 416 * MiB, WS_LO = WS_R + 440 * MiB, WS_MIXIN = WS_R + 696 * MiB, WS_MIX = WS_R;
constexpr size_t WS_UP = WS_R, WS_ACT = WS_R + 704 * MiB, WS_FF = WS_R;
constexpr size_t WS_END = WS_R + 1056 * MiB;
static_assert(WS_WIN + (size_t)PP * DM * 2 <= WS_WL && WS_WL + (size_t)LON * LAK * 2 <= WS_WOUT && WS_WOUT + (size_t)DM * DM * 2 <= WS_WUP && WS_WUP + (size_t)2 * DFF * DM * 2 <= WS_WDN && WS_WDN + (size_t)DM * DFF * 2 <= WS_H, "ws map: weights");
static_assert(WS_H + (size_t)M * DM * 2 <= WS_VF && WS_VF + (size_t)M * RW * 2 <= WS_R, "ws map: H/VF");
static_assert(WS_P + (size_t)M * PP * 2 <= WS_LA && WS_LA + (size_t)M * LAK * 2 <= WS_LO && WS_LO + (size_t)M * LON * 2 <= WS_MIXIN && WS_MIXIN + (size_t)M * DM * 2 <= WS_END, "ws map: mixer");
static_assert(WS_UP + (size_t)M * 2 * DFF * 2 <= WS_ACT && WS_ACT + (size_t)M * DFF * 2 <= WS_END, "ws map: ffn");
constexpr int CW_KMAX = 1024;
constexpr int CW_Q = 2048;
constexpr int CW_BAR = 4096;

constexpr int RING_BYTES = 131072, LDSCTL_OFF = RING_BYTES, MISC_OFF = LDSCTL_OFF + 320, LDS_BYTES = 147456;

#define LDS_WAIT() asm volatile("s_waitcnt lgkmcnt(0)" ::: "memory")

struct Args { const float* in[32]; float* out; unsigned char* ws; int ph_lo, ph_hi, li, pad; };
__device__ __forceinline__ float inv_freq_of(int j) { return j == 0 ? 1.0f : j == 1 ? 0.1939227432012558f : j == 2 ? 0.03760603070259094f : j == 3 ? 0.007292664609849453f : j == 4 ? 0.0014142135623842478f : j == 5 ? 0.00027424818836152554f : j == 6 ? 5.3182957344688475e-05f : 1.0313385246263351e-05f; }
__device__ __forceinline__ float lam_init_of(int l) { return l == 0 ? 0.20000000298023224f : l == 1 ? 0.35550907254219055f : l == 2 ? 0.4707130193710327f : 0.5560582280158997f; }
typedef const Args __attribute__((address_space(4)))* KA;
struct Ctx { LAS unsigned char* lds; int tid, lane, wave, G, vcu, gw, NGW; };

__device__ __forceinline__ float bf_lo(unsigned u) { return __uint_as_float(u << 16); }
__device__ __forceinline__ float bf_hi(unsigned u) { return __uint_as_float(u & 0xffff0000u); }
__device__ __forceinline__ float bf2f(bf16 h) { return __uint_as_float((unsigned)h << 16); }
__device__ __forceinline__ unsigned cvtpk(float lo, float hi) { f32x2_t v = {lo, hi}; bf16x2_t b = __builtin_convertvector(v, bf16x2_t); return __builtin_bit_cast(unsigned, b); }
__device__ __forceinline__ bf16 f2bf(float f) { return (bf16)(cvtpk(f, 0.f) & 0xffffu); }
__device__ __forceinline__ void unpack8(const v4u v, float* f) { f[0] = bf_lo(v.x); f[1] = bf_hi(v.x); f[2] = bf_lo(v.y); f[3] = bf_hi(v.y); f[4] = bf_lo(v.z); f[5] = bf_hi(v.z); f[6] = bf_lo(v.w); f[7] = bf_hi(v.w); }
__device__ __forceinline__ v4u pack8(const float* f) { v4u o; o.x = cvtpk(f[0], f[1]); o.y = cvtpk(f[2], f[3]); o.z = cvtpk(f[4], f[5]); o.w = cvtpk(f[6], f[7]); return o; }
__device__ __forceinline__ float wave_sum(float v) {
#pragma unroll
    for (int o = 1; o < 64; o <<= 1) v += __shfl_xor(v, o);
    return v;
}
#define DPPF(x, ctrl) __int_as_float(__builtin_amdgcn_update_dpp(0, __float_as_int(x), (ctrl), 0xf, 0xf, true))
__device__ __forceinline__ float sigmoidf_(float x) { return __builtin_amdgcn_rcpf(1.f + __expf(-x)); }
__device__ __forceinline__ float tanhf_(float x) { return 1.f - 2.f * __builtin_amdgcn_rcpf(1.f + __expf(2.f * x)); }

__device__ __forceinline__ void transpose_item(const float* __restrict__ W, int K, int N, bf16* WT, int row_off, float scale, LAS float* scr, int item, int lane) {
    const int nblk = N / 32, kb = item / nblk, nb = item % nblk, k0 = 64 * kb, n0 = 32 * nb;
    float wv[32];
#pragma unroll
    for (int i = 0; i < 32; ++i) wv[i] = __builtin_nontemporal_load(W + (size_t)(k0 + 2 * i + (lane >> 5)) * N + n0 + (lane & 31));
#pragma unroll
    for (int i = 0; i < 32; ++i) scr[(2 * i + (lane >> 5)) * 33 + (lane & 31)] = wv[i];
    LDS_WAIT(); asm volatile("" ::: "memory");
    const int c = lane & 7;
#pragma unroll
    for (int j = 0; j < 4; ++j) { const int n = (lane >> 3) + 8 * j; const LAS float* s = scr + (8 * c) * 33 + n;
        v4u o; o.x = cvtpk(s[0 * 33] * scale, s[1 * 33] * scale); o.y = cvtpk(s[2 * 33] * scale, s[3 * 33] * scale); o.z = cvtpk(s[4 * 33] * scale, s[5 * 33] * scale); o.w = cvtpk(s[6 * 33] * scale, s[7 * 33] * scale);
        *(v4u*)(WT + (size_t)(row_off + n0 + n) * K + k0 + 8 * c) = o; }
    LDS_WAIT(); asm volatile("" ::: "memory");
}

__device__ __forceinline__ void ph_wconv(KA A, const Ctx& C, int l) {
    bf16* Win = (bf16*)(A->ws + WS_WIN); bf16* WL = (bf16*)(A->ws + WS_WL); bf16* Wout = (bf16*)(A->ws + WS_WOUT); bf16* Wup = (bf16*)(A->ws + WS_WUP); bf16* Wdn = (bf16*)(A->ws + WS_WDN);
    LAS float* scr = (LAS float*)(C.lds + C.wave * 16384);
    const float* w_in = A->in[6] + (size_t)l * DM * IN_COLS;
    const float* w_mv = A->in[7] + (size_t)(l > 0 ? l - 1 : 0) * DM * 32;
    const float* w_out = A->in[27] + (size_t)l * DM * DM;
    const float* w_up = A->in[28] + (size_t)l * DM * 2 * DFF;
    const float* w_dn = A->in[31] + (size_t)l * DFF * DM;
    constexpr int I_IN = 32 * 201, I_MV = 32, I_OUT = 32 * 64, I_UP = 32 * 352, I_DN = 88 * 64;
    const int i_mv = l > 0 ? I_MV : 0;
    const int NIT = I_IN + i_mv + I_OUT + I_UP + I_DN;
    for (int it = C.gw; it < NIT; it += C.NGW) {
        int r = it;
        if (r < I_IN) { const int n0 = 32 * (r % 201); const float sc = (n0 >= C_Q && n0 < C_KD) ? QSCALE : 1.f; transpose_item(w_in, DM, IN_COLS, Win, 0, sc, scr, r, C.lane); continue; } r -= I_IN;
        if (r < i_mv) { transpose_item(w_mv, DM, 32, Win, IN_COLS, 1.f, scr, r, C.lane); continue; } r -= i_mv;
        if (r < I_OUT) { transpose_item(w_out, DM, DM, Wout, 0, 1.f, scr, r, C.lane); continue; } r -= I_OUT;
        if (r < I_UP) { const int n0 = 32 * (r % 352);
            const int n1 = n0 < DFF ? 256 * (n0 / 128) + (n0 % 128) : 256 * ((n0 - DFF) / 128) + 128 + ((n0 - DFF) % 128);
            transpose_item(w_up, DM, 2 * DFF, Wup, n1 - n0, 1.f, scr, r, C.lane); continue; } r -= I_UP;
        transpose_item(w_dn, DFF, DM, Wdn, 0, 1.f, scr, r, C.lane);
    }
    {
        const int r0 = l > 0 ? IN_COLS + 32 : IN_COLS; const int nch = (PP - r0) * (DM / 8);
        for (int i = C.gw * 64 + C.lane; i < nch; i += C.NGW * 64) *(v4u*)(Win + (size_t)r0 * DM + (size_t)i * 8) = (v4u){0u, 0u, 0u, 0u};
    }
    {
        const float* w2 = A->in[11] + (size_t)l * 64 * RW; const float* a2 = A->in[13] + (size_t)l * 64 * RW; const float* g2 = A->in[14] + (size_t)l * 160 * RW;
        const float* v2 = A->in[21] + (size_t)(l > 0 ? l - 1 : 0) * 32 * RW;
        for (int i = C.gw * 64 + C.lane; i < LON * (LAK / 8); i += C.NGW * 64) {
            const int n = i % LON, k0 = (i / LON) * 8, blk = n >> 10, nn = n & 1023; float val[8];
#pragma unroll
            for (int e = 0; e < 8; ++e) val[e] = 0.f;
            if (blk == 0) { if (k0 < 64) {
#pragma unroll
                for (int e = 0; e < 8; ++e) val[e] = w2[(size_t)(k0 + e) * RW + nn]; } }
            else if (blk == 1) { if (k0 >= 64 && k0 < 128) {
#pragma unroll
                for (int e = 0; e < 8; ++e) val[e] = a2[(size_t)(k0 - 64 + e) * RW + nn]; } }
            else if (blk == 2) { if (k0 >= 128 && k0 < 288) {
#pragma unroll
                for (int e = 0; e < 8; ++e) val[e] = g2[(size_t)(k0 - 128 + e) * RW + nn]; } }
            else { if (l > 0 && k0 >= 288 && k0 < 320) {
#pragma unroll
                for (int e = 0; e < 8; ++e) val[e] = v2[(size_t)(k0 - 288 + e) * RW + nn]; } }
            *(v4u*)(WL + (size_t)n * LAK + k0) = pack8(val);
        }
    }
}

__device__ __forceinline__ void ph_prologue(KA A, const Ctx& C) {
    float* CS = (float*)(A->ws + WS_CS); const int* pos = (const int*)A->in[1];
    for (int i = C.gw * 64 + C.lane; i < M * 8; i += C.NGW * 64) {
        const int m = i >> 3, j = i & 7; const float ang = (float)pos[m] * inv_freq_of(j);
        const double rev = (double)ang * 0.15915494309189535; const float fr = (float)(rev - floor(rev));
        CS[m * 16 + j] = __builtin_amdgcn_cosf(fr); CS[m * 16 + 8 + j] = __builtin_amdgcn_sinf(fr);
    }
    const float* x = A->in[0]; const float* g = A->in[2]; bf16* H = (bf16*)((unsigned char*)A->out + OUT_H);
    for (int m = C.gw; m < M; m += C.NGW) {
        float v[32]; float ss = 0.f;
#pragma unroll
        for (int j = 0; j < 4; ++j) { const int col = (j * 64 + C.lane) * 8; const f32x4 a = *(const f32x4*)(x + (size_t)m * DM + col), b = *(const f32x4*)(x + (size_t)m * DM + col + 4);
            v[8 * j + 0] = a.x; v[8 * j + 1] = a.y; v[8 * j + 2] = a.z; v[8 * j + 3] = a.w; v[8 * j + 4] = b.x; v[8 * j + 5] = b.y; v[8 * j + 6] = b.z; v[8 * j + 7] = b.w;
#pragma unroll
            for (int e = 0; e < 8; ++e) ss += v[8 * j + e] * v[8 * j + e]; }
        const float r = rsqrtf(wave_sum(ss) * (1.f / DM) + 1e-6f);
#pragma unroll
        for (int j = 0; j < 4; ++j) { const int col = (j * 64 + C.lane) * 8; const f32x4 a = *(const f32x4*)(g + col), b = *(const f32x4*)(g + col + 4);
            float o[8]; o[0] = v[8 * j] * r * a.x; o[1] = v[8 * j + 1] * r * a.y; o[2] = v[8 * j + 2] * r * a.z; o[3] = v[8 * j + 3] * r * a.w; o[4] = v[8 * j + 4] * r * b.x; o[5] = v[8 * j + 5] * r * b.y; o[6] = v[8 * j + 6] * r * b.z; o[7] = v[8 * j + 7] * r * b.w;
            *(v4u*)(H + (size_t)m * DM + col) = pack8(o); }
    }
}

__device__ __forceinline__ void ph_res(const Ctx& C, const bf16* Y, const float* xin32, const bf16* xin16, bf16* xout16, float* xout32, const float* gpost, const float* gnext, bf16* H) {
    f32x4 gp[8], gn[8];
#pragma unroll
    for (int j = 0; j < 4; ++j) { const int col = (j * 64 + C.lane) * 8; gp[2 * j] = *(const f32x4*)(gpost + col); gp[2 * j + 1] = *(const f32x4*)(gpost + col + 4);
        if (gnext) { gn[2 * j] = *(const f32x4*)(gnext + col); gn[2 * j + 1] = *(const f32x4*)(gnext + col + 4); } }
    for (int m = C.gw; m < M; m += C.NGW) {
        float y[32]; float ss = 0.f;
#pragma unroll
        for (int j = 0; j < 4; ++j) { const v4u v = __builtin_nontemporal_load((const v4u*)(Y + (size_t)m * DM + (j * 64 + C.lane) * 8)); unpack8(v, y + 8 * j);
#pragma unroll
            for (int e = 0; e < 8; ++e) ss += y[8 * j + e] * y[8 * j + e]; }
        const float r1 = rsqrtf(wave_sum(ss) * (1.f / DM) + 1e-6f);
        float ss2 = 0.f;
#pragma unroll
        for (int j = 0; j < 4; ++j) { const int col = (j * 64 + C.lane) * 8; const size_t off = (size_t)m * DM + col;
            float xv[8];
            if (xin32) { const f32x4 x0 = *(const f32x4*)(xin32 + off), x1 = *(const f32x4*)(xin32 + off + 4); xv[0] = x0.x; xv[1] = x0.y; xv[2] = x0.z; xv[3] = x0.w; xv[4] = x1.x; xv[5] = x1.y; xv[6] = x1.z; xv[7] = x1.w; }
            else unpack8(__builtin_nontemporal_load((const v4u*)(xin16 + off)), xv);
            const f32x4 g0 = gp[2 * j], g1 = gp[2 * j + 1];
            const float gg[8] = {g0.x, g0.y, g0.z, g0.w, g1.x, g1.y, g1.z, g1.w};
#pragma unroll
            for (int e = 0; e < 8; ++e) { y[8 * j + e] = xv[e] + y[8 * j + e] * r1 * gg[e]; }
            if (xout32) { *(f32x4*)(xout32 + off) = (f32x4){y[8 * j], y[8 * j + 1], y[8 * j + 2], y[8 * j + 3]}; *(f32x4*)(xout32 + off + 4) = (f32x4){y[8 * j + 4], y[8 * j + 5], y[8 * j + 6], y[8 * j + 7]}; }
            else { __builtin_nontemporal_store(pack8(y + 8 * j), (v4u*)(xout16 + off)); float t[8]; unpack8(pack8(y + 8 * j), t);
#pragma unroll
                for (int e = 0; e < 8; ++e) y[8 * j + e] = t[e]; }
#pragma unroll
            for (int e = 0; e < 8; ++e) ss2 += y[8 * j + e] * y[8 * j + e]; }
        if (gnext) {
            const float r2 = rsqrtf(wave_sum(ss2) * (1.f / DM) + 1e-6f);
#pragma unroll
            for (int j = 0; j < 4; ++j) { const int col = (j * 64 + C.lane) * 8; const f32x4 g0 = gn[2 * j], g1 = gn[2 * j + 1];
                float o[8]; o[0] = y[8 * j] * r2 * g0.x; o[1] = y[8 * j + 1] * r2 * g0.y; o[2] = y[8 * j + 2] * r2 * g0.z; o[3] = y[8 * j + 3] * r2 * g0.w;
                o[4] = y[8 * j + 4] * r2 * g1.x; o[5] = y[8 * j + 5] * r2 * g1.y; o[6] = y[8 * j + 6] * r2 * g1.z; o[7] = y[8 * j + 7] * r2 * g1.w;
                *(v4u*)(H + (size_t)m * DM + col) = pack8(o); }
        }
    }
}

__device__ __forceinline__ float shiftcol(const bf16* Pm, bool has_prev, int col, float mu) {
    const float p = bf2f(Pm[col]); const float q = has_prev ? bf2f(Pm[col - PP]) : 0.f; return p + mu * (q - p);
}
#ifndef E0_RB
#define E0_RB 4
#endif
__device__ __forceinline__ void ph_e0(KA A, const Ctx& C, int l) {
    bf16* P = (bf16*)(A->ws + WS_P); bf16* LA = (bf16*)(A->ws + WS_LA); const float* CS = (const float*)(A->ws + WS_CS);
    const float* mu = A->in[8] + (size_t)l * 3360; const float* mumv = A->in[9] + (size_t)(l > 0 ? l - 1 : 0) * 32;
    const int lane = C.lane;
    const float mu_wl = mu[C_WL + lane], mu_al = mu[C_AL + lane], mu_g0 = mu[C_GL + lane], mu_g1 = mu[C_GL + 64 + lane];
    const float mu_4 = lane < 32 ? mu[C_GL + 128 + lane] : (l > 0 ? mumv[lane - 32] : 0.f);
    unsigned* kmaxw = (unsigned*)(A->ws + WS_CTL) + CW_KMAX + 128 * l;
    constexpr int RB = E0_RB;
    const int rpw = ((M + C.NGW - 1) / C.NGW + RB - 1) & ~(RB - 1), m_lo = C.gw * rpw, m_hi = (m_lo + rpw < M) ? m_lo + rpw : M;
    float kmx = 0.f; int kb = (m_lo < M) ? (m_lo >> 12) : 0;
    const int c4 = lane < 32 ? C_GL + 128 + lane : C_MV + lane - 32;
    for (int m0 = m_lo; m0 < m_hi; m0 += RB) {
        bf16* P0 = P + (size_t)m0 * PP; bf16* L0 = LA + (size_t)m0 * LAK; const bool hp0 = (m0 & (SEQ - 1)) != 0;
        if ((m0 >> 12) != kb) { if ((lane & 3) == 0) atomicMax(kmaxw + kb * 16 + (lane >> 2), __float_as_uint(kmx)); kmx = 0.f; kb = m0 >> 12; }
        v4u kA[RB], kB[RB]; bf16 nr[5][RB + 1]; v4u rlo[RB / 2], rhi[RB / 2]; f32x4 rc[RB / 2][4];
#pragma unroll
        for (int r = 0; r < RB; ++r) { kA[r] = *(const v4u*)(P0 + r * PP + C_KD + lane * 16); kB[r] = *(const v4u*)(P0 + r * PP + C_KD + lane * 16 + 8); }
        bf16* Prot = P0 + (lane >> 5) * PP + (((lane & 31) < 16) ? C_Q + (lane & 31) * 64 : C_KD + ((lane & 31) - 16) * 64);
#pragma unroll
        for (int rr = 0; rr < RB / 2; ++rr) { rlo[rr] = *(const v4u*)(Prot + rr * 2 * PP); rhi[rr] = *(const v4u*)(Prot + rr * 2 * PP + 8);
            const float* cs = CS + (size_t)(m0 + 2 * rr + (lane >> 5)) * 16;
#pragma unroll
            for (int q = 0; q < 4; ++q) rc[rr][q] = *(const f32x4*)(cs + 4 * q); }
#pragma unroll
        for (int r = 0; r < RB + 1; ++r) { const bool ok = r > 0 || hp0; const bf16* Pr = P0 + (r - 1) * PP;
            nr[0][r] = ok ? Pr[C_WL + lane] : (bf16)0; nr[1][r] = ok ? Pr[C_AL + lane] : (bf16)0; nr[2][r] = ok ? Pr[C_GL + lane] : (bf16)0;
            nr[3][r] = ok ? Pr[C_GL + 64 + lane] : (bf16)0; nr[4][r] = ok ? Pr[c4] : (bf16)0; }
#pragma unroll
        for (int r = 0; r < RB; ++r) {
            bf16* La = L0 + r * LAK; bf16* Pm = P0 + r * PP;
            {   float f[16]; unpack8(kA[r], f); unpack8(kB[r], f + 8);
                float n2 = 0.f;
#pragma unroll
                for (int e = 0; e < 16; ++e) n2 += f[e] * f[e];
                n2 += DPPF(n2, 0xB1); n2 += DPPF(n2, 0x4E); kmx = fmaxf(kmx, n2); }
            float sh[5];
#pragma unroll
            for (int i = 0; i < 5; ++i) { const float p = bf2f(nr[i][r + 1]), q = bf2f(nr[i][r]); sh[i] = p + (i == 0 ? mu_wl : i == 1 ? mu_al : i == 2 ? mu_g0 : i == 3 ? mu_g1 : mu_4) * (q - p); }
            La[lane] = f2bf(tanhf_(sh[0]));
            La[64 + lane] = f2bf(sh[1]);
            La[128 + lane] = f2bf(sigmoidf_(sh[2]));
            La[192 + lane] = f2bf(sigmoidf_(sh[3]));
            La[256 + lane] = f2bf(lane < 32 ? sigmoidf_(sh[4]) : (l > 0 ? sh[4] : 0.f));
            La[320 + lane] = 0;
        }
#pragma unroll
        for (int rr = 0; rr < RB / 2; ++rr) { float a[8], b[8], oa[8], ob[8]; unpack8(rlo[rr], a); unpack8(rhi[rr], b);
            const float c[8] = {rc[rr][0].x, rc[rr][0].y, rc[rr][0].z, rc[rr][0].w, rc[rr][1].x, rc[rr][1].y, rc[rr][1].z, rc[rr][1].w};
            const float sn[8] = {rc[rr][2].x, rc[rr][2].y, rc[rr][2].z, rc[rr][2].w, rc[rr][3].x, rc[rr][3].y, rc[rr][3].z, rc[rr][3].w};
#pragma unroll
            for (int e = 0; e < 8; ++e) { oa[e] = a[e] * c[e] - b[e] * sn[e]; ob[e] = b[e] * c[e] + a[e] * sn[e]; }
            *(v4u*)(Prot + rr * 2 * PP) = pack8(oa); *(v4u*)(Prot + rr * 2 * PP + 8) = pack8(ob); }
    }
    if (m_lo < M && (lane & 3) == 0) atomicMax(kmaxw + kb * 16 + (lane >> 2), __float_as_uint(kmx));
}

__device__ __forceinline__ float gelu_tanh_(float a) { const float u = 0.7978845608028654f * (a + 0.044715f * a * a * a); return a * __builtin_amdgcn_rcpf(1.f + __expf(-2.f * u)); }
__device__ __forceinline__ void ph_act(KA A, const Ctx& C, int l) {
    const bf16* UP = (const bf16*)(A->ws + WS_UP); bf16* ACT = (bf16*)(A->ws + WS_ACT);
    const float* cw = A->in[29] + (size_t)l * 3 * DFF; const float* cb = A->in[30] + (size_t)l * DFF;
    for (int it = C.gw; it < (M / 32) * 11; it += C.NGW) {
        const int rb = it / 11, cc = it % 11, m0 = rb * 32, col = cc * 512 + C.lane * 8;
        float w0[8], w1[8], w2[8], bb[8];
#pragma unroll
        for (int e = 0; e < 8; ++e) { w0[e] = cw[col + e]; w1[e] = cw[DFF + col + e]; w2[e] = cw[2 * DFF + col + e]; bb[e] = cb[col + e]; }
        float gm2[8], gm1[8];
#pragma unroll
        for (int e = 0; e < 8; ++e) { gm2[e] = 0.f; gm1[e] = 0.f; }
        if ((m0 & (SEQ - 1)) != 0) { unpack8(*(const v4u*)(UP + (size_t)(m0 - 2) * 2 * DFF + col), gm2); unpack8(*(const v4u*)(UP + (size_t)(m0 - 1) * 2 * DFF + col), gm1); }
        for (int i0 = 0; i0 < 32; i0 += 4) {
            v4u gr[4], ur[4];
#pragma unroll
            for (int r = 0; r < 4; ++r) { const size_t ro = (size_t)(m0 + i0 + r) * 2 * DFF; gr[r] = __builtin_nontemporal_load((const v4u*)(UP + ro + col)); ur[r] = __builtin_nontemporal_load((const v4u*)(UP + ro + DFF + col)); }
#pragma unroll
            for (int r = 0; r < 4; ++r) { float g[8], u[8], o[8]; unpack8(gr[r], g); unpack8(ur[r], u);
#pragma unroll
                for (int e = 0; e < 8; ++e) { const float a = w0[e] * gm2[e] + w1[e] * gm1[e] + w2[e] * g[e] + bb[e]; o[e] = gelu_tanh_(a) * u[e]; gm2[e] = gm1[e]; gm1[e] = g[e]; }
                *(v4u*)(ACT + (size_t)(m0 + i0 + r) * DFF + col) = pack8(o); }
        }
    }
}

constexpr int BND_OFF = RING_BYTES + 1024;
constexpr size_t WS_GL = WS_UP, WS_R01 = WS_UP + 4 * MiB;
template <int CTRL> __device__ __forceinline__ float dpp_keep(float old, float src) { return __int_as_float(__builtin_amdgcn_update_dpp(__float_as_int(old), __float_as_int(src), CTRL, 0xf, 0xf, false)); }
__device__ __forceinline__ v2u pk4a(const f32x4 x) { v2u o; o.x = cvtpk(x[0], x[1]); o.y = cvtpk(x[2], x[3]); return o; }
struct EpiAct {
    static constexpr bool PERM = true, AFTER_DRAIN = false;
    bf16* ACT; const float* cw; const float* cb; bf16* GL; bf16* R01; LAS float* bnd;
    __device__ __forceinline__ void operator()(const pg8::f32x4 (&acc)[2][2][4][2], const pg8::Unit& u, int wr, int wc, int fr, int fq) const {
        const int c32 = wc * 32 + 8 * fq, ch0 = u.pn * 128 + c32;
        f32x4 w0[2], w1[2], w2[2], bb[2];
#pragma unroll
        for (int n = 0; n < 2; ++n) { w0[n] = *(const f32x4*)(cw + ch0 + 4 * n); w1[n] = *(const f32x4*)(cw + DFF + ch0 + 4 * n); w2[n] = *(const f32x4*)(cw + 2 * DFF + ch0 + 4 * n); bb[n] = *(const f32x4*)(cb + ch0 + 4 * n); }
        if (fr >= 14) {
#pragma unroll
            for (int ai = 0; ai < 2; ++ai)
#pragma unroll
                for (int n = 0; n < 2; ++n) *(LAS f32x4*)(bnd + ((2 * ai + wr) * 2 + (fr - 14)) * 128 + c32 + 4 * n) = acc[ai][0][3][n];
            if (wr == 1) {
                v2u p0 = pk4a(acc[1][0][3][0]), p1 = pk4a(acc[1][0][3][1]); *(v4u*)(GL + ((size_t)u.pm * 2 + (fr - 14)) * DFF + ch0) = (v4u){p0.x, p0.y, p1.x, p1.y}; }
        }
        if (wr == 0 && fr < 2) {
            v2u p0 = pk4a(acc[0][0][0][0]), p1 = pk4a(acc[0][0][0][1]); *(v4u*)(R01 + (((size_t)u.pm * 2 + fr) * 2 + 0) * DFF + ch0) = (v4u){p0.x, p0.y, p1.x, p1.y};
            p0 = pk4a(acc[0][1][0][0]); p1 = pk4a(acc[0][1][0][1]); *(v4u*)(R01 + (((size_t)u.pm * 2 + fr) * 2 + 1) * DFF + ch0) = (v4u){p0.x, p0.y, p1.x, p1.y}; }
        asm volatile("s_waitcnt lgkmcnt(0)" ::: "memory"); __builtin_amdgcn_s_barrier(); asm volatile("" ::: "memory");
#pragma unroll
        for (int ai = 0; ai < 2; ++ai)
#pragma unroll
            for (int m = 0; m < 4; ++m) {
                float o[8];
#pragma unroll
                for (int n = 0; n < 2; ++n) {
                    const f32x4 g = acc[ai][0][m][n], up = acc[ai][1][m][n]; f32x4 o1, o2;
                    if (m > 0) {
#pragma unroll
                        for (int e = 0; e < 4; ++e) { o1[e] = DPPF(acc[ai][0][m - 1][n][e], 0x121); o2[e] = DPPF(acc[ai][0][m - 1][n][e], 0x122); } }
                    else if (2 * ai + wr == 0) { o1 = (f32x4){0.f, 0.f, 0.f, 0.f}; o2 = o1; }
                    else { const LAS float* bp = bnd + ((2 * ai + wr - 1) * 2) * 128 + c32 + 4 * n; o1 = *(const LAS f32x4*)(bp + 128); o2 = *(const LAS f32x4*)(bp + (fr == 1 ? 128 : 0)); }
#pragma unroll
                    for (int e = 0; e < 4; ++e) { const float p1 = dpp_keep<0x111>(o1[e], g[e]), p2 = dpp_keep<0x112>(o2[e], g[e]);
                        const float a = w0[n][e] * p2 + w1[n][e] * p1 + w2[n][e] * g[e] + bb[n][e];
                        const float ex = __builtin_amdgcn_exp2f(a * fmaf(-0.10294324f, a * a, -2.3022082f)); o[4 * n + e] = (a * up[e]) * __builtin_amdgcn_rcpf(1.f + ex); }
                }
                *(v4u*)(ACT + (size_t)(u.pm * 256 + wr * 64 + fr + ai * 128 + m * 16) * DFF + ch0) = pack8(o);
            }
    }
};
__device__ __forceinline__ void ph_actfix(KA A, const Ctx& C, int l) {
    const bf16* GL = (const bf16*)(A->ws + WS_GL); const bf16* R01 = (const bf16*)(A->ws + WS_R01); bf16* ACT = (bf16*)(A->ws + WS_ACT);
    const float* cw = A->in[29] + (size_t)l * 3 * DFF; const float* cb = A->in[30] + (size_t)l * DFF;
    for (int i = C.gw * 64 + C.lane; i < (M / 256) * (DFF / 8); i += C.NGW * 64) {
        const int pm = i / (DFF / 8), ch0 = (i % (DFF / 8)) * 8; const bool hp = (pm % (SEQ / 256)) != 0;
        float g0[8], g1[8], u0[8], u1[8], q1[8], q2[8], w0[8], w1[8], w2[8], bb[8];
        unpack8(*(const v4u*)(R01 + (((size_t)pm * 2 + 0) * 2 + 0) * DFF + ch0), g0); unpack8(*(const v4u*)(R01 + (((size_t)pm * 2 + 0) * 2 + 1) * DFF + ch0), u0);
        unpack8(*(const v4u*)(R01 + (((size_t)pm * 2 + 1) * 2 + 0) * DFF + ch0), g1); unpack8(*(const v4u*)(R01 + (((size_t)pm * 2 + 1) * 2 + 1) * DFF + ch0), u1);
        if (hp) { unpack8(*(const v4u*)(GL + ((size_t)(pm - 1) * 2 + 1) * DFF + ch0), q1); unpack8(*(const v4u*)(GL + ((size_t)(pm - 1) * 2 + 0) * DFF + ch0), q2); }
        else {
#pragma unroll
            for (int e = 0; e < 8; ++e) { q1[e] = 0.f; q2[e] = 0.f; } }
#pragma unroll
        for (int e = 0; e < 8; ++e) { w0[e] = cw[ch0 + e]; w1[e] = cw[DFF + ch0 + e]; w2[e] = cw[2 * DFF + ch0 + e]; bb[e] = cb[ch0 + e]; }
        float o0[8], o1[8];
#pragma unroll
        for (int e = 0; e < 8; ++e) { o0[e] = gelu_tanh_(w0[e] * q2[e] + w1[e] * q1[e] + w2[e] * g0[e] + bb[e]) * u0[e]; o1[e] = gelu_tanh_(w0[e] * q1[e] + w1[e] * g0[e] + w2[e] * g1[e] + bb[e]) * u1[e]; }
        *(v4u*)(ACT + (size_t)(pm * 256) * DFF + ch0) = pack8(o0); *(v4u*)(ACT + (size_t)(pm * 256 + 1) * DFF + ch0) = pack8(o1);
    }
}

__device__ __forceinline__ int crow(int r, int hi) { return (r & 3) + 8 * (r >> 2) + 4 * hi; }
constexpr int ATT_KROW = 72;
constexpr int ATT_KBUF = 2 * 64 * ATT_KROW * 2, ATT_VBUF = 128 * ATT_KROW * 2;
__device__ __forceinline__ void att_qk(f32x16& s0, f32x16& s1, const LAS unsigned char* kbuf, int mp, const bf16x8* qf, int r32, int hi) {
    s0 = (f32x16){0.f, 0.f, 0.f, 0.f, 0.f, 0.f, 0.f, 0.f, 0.f, 0.f, 0.f, 0.f, 0.f, 0.f, 0.f, 0.f}; s1 = s0;
    const LAS unsigned char* kp = kbuf + ((mp * 64 + r32) * ATT_KROW + hi * 8) * 2;
#pragma unroll
    for (int ks = 0; ks < 4; ++ks) {
        const bf16x8 a0 = *(const LAS bf16x8*)(kp + ks * 32), a1 = *(const LAS bf16x8*)(kp + 32 * ATT_KROW * 2 + ks * 32);
        s0 = __builtin_amdgcn_mfma_f32_32x32x16_bf16(a0, qf[ks], s0, 0, 0, 0);
        s1 = __builtin_amdgcn_mfma_f32_32x32x16_bf16(a1, qf[ks], s1, 0, 0, 0);
    }
}
__device__ __forceinline__ void att_mask(f32x16& s0, f32x16& s1, int kv0, int qa, int hi) {
#pragma unroll
    for (int r = 0; r < 16; ++r) { const int kv = kv0 + crow(r, hi); if (kv > qa) s0[r] = -INFINITY; if (kv + 32 > qa) s1[r] = -INFINITY; }
}
__device__ __forceinline__ void att_stats(const f32x16& s0, const f32x16& s1, float& m, float& l) {
    float tm = fmaxf(s0[0], s1[0]);
#pragma unroll
    for (int r = 1; r < 16; ++r) tm = fmaxf(tm, fmaxf(s0[r], s1[r]));
    tm = fmaxf(tm, __shfl_xor(tm, 32));
    const float mn = fmaxf(m, tm); float acc = 0.f;
#pragma unroll
    for (int r = 0; r < 16; ++r) acc += __builtin_amdgcn_exp2f(s0[r] - mn) + __builtin_amdgcn_exp2f(s1[r] - mn);
    l = l * __builtin_amdgcn_exp2f(m - mn) + acc; m = mn;
}

__device__ __forceinline__ void ph_attn(KA A, const Ctx& C, int l, unsigned* queue  ) {
    const int tid = C.tid, lane = C.lane, wave = C.wave, r32 = lane & 31, hi = lane >> 5;
    const bf16* P = (const bf16*)(A->ws + WS_P); bf16* MIXIN = (bf16*)(A->ws + WS_MIXIN);
    float lam;
    { const float a1 = A->in[22][l * 64 + lane] * A->in[23][l * 64 + lane], a2 = A->in[24][l * 64 + lane] * A->in[25][l * 64 + lane];
      lam = __expf(wave_sum(a1)) - __expf(wave_sum(a2)) + lam_init_of(l); }
    const float oscale = 1.f - lam_init_of(l);
    const float* swp = A->in[26] + l * 128;
    LAS unsigned char* const kbase = C.lds; LAS unsigned char* const vbase = C.lds + 2 * ATT_KBUF;
    const int k_kv = tid >> 4, k_part = tid & 15;
    const unsigned k_goff = (unsigned)(k_kv * PP + k_part * 8) * 2u;
    const int k_loff = (((k_part >> 3) * 64 + k_kv) * ATT_KROW + (k_part & 7) * 8) * 2;
    const int v_kv = tid & 63, v_ch = tid >> 6;
    const unsigned v_goff = (unsigned)(v_kv * PP + v_ch * 8) * 2u;
    const int v_pos = (v_kv & ~12) | ((v_kv & 4) << 1) | ((v_kv & 8) >> 1);
    const int v_loff = (v_ch * 8 * ATT_KROW + v_pos) * 2;
    LAS unsigned* const qslot = (LAS unsigned*)(C.lds + LDSCTL_OFF + 64);
    for (;;) {
        if (tid == 0) *qslot = __hip_atomic_fetch_add(queue, 1u, __ATOMIC_RELAXED, __HIP_MEMORY_SCOPE_AGENT);
        __syncthreads();
        const unsigned u = (unsigned)__builtin_amdgcn_readfirstlane((int)*qslot);
        __syncthreads();
        if (u >= 64u * 16u) break;
        const int bh = (int)(u >> 4), qb = 15 - (int)(u & 15u);
        const int b = bh >> 3, h = bh & 7, q0 = qb * 256, qw = q0 + 32 * wave, qa = qw + r32;
        const bf16* Pb = P + (size_t)b * SEQ * PP;
        const bf16* Kg = Pb + C_KD + h * 128; const bf16* Vg = Pb + C_VD + h * 128;
        bf16x8 qf[2][4];
        { const unsigned qoff = (unsigned)(qa * PP + C_Q + h * 128 + hi * 8) * 2u;
#pragma unroll
          for (int mp = 0; mp < 2; ++mp)
#pragma unroll
              for (int ks = 0; ks < 4; ++ks) qf[mp][ks] = *(const bf16x8*)((const unsigned char*)Pb + (qoff + (unsigned)(mp * 128 + ks * 32))); }
        const int NT = 4 * (qb + 1), my_nt = (qw + 31) / 64 + 1;
        v4u kreg[2], vreg[2];
#define ATT_LOADK(t) do { _Pragma("unroll") for (int i_ = 0; i_ < 2; ++i_) kreg[i_] = *(const v4u*)((const unsigned char*)Kg + (k_goff + (unsigned)(((t) * 64 + 32 * i_) * PP * 2))); } while (0)
#define ATT_STOREK(buf) do { _Pragma("unroll") for (int i_ = 0; i_ < 2; ++i_) *(LAS v4u*)(kbase + (buf) * ATT_KBUF + k_loff + i_ * 32 * ATT_KROW * 2) = kreg[i_]; } while (0)
#define ATT_LOADV(t) do { _Pragma("unroll") for (int i_ = 0; i_ < 2; ++i_) vreg[i_] = *(const v4u*)((const unsigned char*)Vg + (v_goff + (unsigned)((t) * 64 * PP * 2 + i_ * 128))); } while (0)
#define ATT_STOREV(buf) do { _Pragma("unroll") for (int i_ = 0; i_ < 2; ++i_) { LAS unsigned char* vp_ = vbase + (buf) * ATT_VBUF + v_loff + i_ * 64 * ATT_KROW * 2; \
            _Pragma("unroll") for (int e_ = 0; e_ < 8; ++e_) { const unsigned w_ = vreg[i_][e_ >> 1]; *(LAS unsigned short*)(vp_ + e_ * ATT_KROW * 2) = (unsigned short)((e_ & 1) ? (w_ >> 16) : (w_ & 0xffffu)); } } } while (0)
        float m1 = -INFINITY, l1 = 0.f, m2 = -INFINITY, l2 = 0.f;
        ATT_LOADK(0); ATT_STOREK(0); __syncthreads();
        for (int t = 0; t < NT; ++t) {
            if (t + 1 < NT) ATT_LOADK(t + 1);
            if (t < my_nt) {
                const LAS unsigned char* kb = kbase + (t & 1) * ATT_KBUF; const bool msk = (t * 64 + 63 > qw);
                f32x16 s0, s1;
                att_qk(s0, s1, kb, 0, qf[0], r32, hi); if (msk) att_mask(s0, s1, t * 64, qa, hi); att_stats(s0, s1, m1, l1);
                att_qk(s0, s1, kb, 1, qf[1], r32, hi); if (msk) att_mask(s0, s1, t * 64, qa, hi); att_stats(s0, s1, m2, l2);
            }
            if (t + 1 < NT) ATT_STOREK((t + 1) & 1);
            __syncthreads();
        }
        l1 += __shfl_xor(l1, 32); l2 += __shfl_xor(l2, 32);
        const float c1 = 1.f / l1, c2 = lam / l2;
        f32x16 o[4];
#pragma unroll
        for (int d0 = 0; d0 < 4; ++d0) o[d0] = (f32x16){0.f, 0.f, 0.f, 0.f, 0.f, 0.f, 0.f, 0.f, 0.f, 0.f, 0.f, 0.f, 0.f, 0.f, 0.f, 0.f};
        ATT_LOADK(0); ATT_LOADV(0); ATT_STOREK(0); ATT_STOREV(0); __syncthreads();
        for (int t = 0; t < NT; ++t) {
            if (t + 1 < NT) { ATT_LOADK(t + 1); ATT_LOADV(t + 1); }
            if (t < my_nt) {
                const LAS unsigned char* kb = kbase + (t & 1) * ATT_KBUF; const LAS unsigned char* vb = vbase + (t & 1) * ATT_VBUF; const bool msk = (t * 64 + 63 > qw);
                f32x16 a0, a1, b0, b1;
                att_qk(a0, a1, kb, 0, qf[0], r32, hi); att_qk(b0, b1, kb, 1, qf[1], r32, hi);
                if (msk) { att_mask(a0, a1, t * 64, qa, hi); att_mask(b0, b1, t * 64, qa, hi); }
#pragma unroll
                for (int r = 0; r < 16; ++r) {
                    a0[r] = __builtin_amdgcn_exp2f(a0[r] - m1) * c1 - __builtin_amdgcn_exp2f(b0[r] - m2) * c2;
                    a1[r] = __builtin_amdgcn_exp2f(a1[r] - m1) * c1 - __builtin_amdgcn_exp2f(b1[r] - m2) * c2;
                }
                bf16x8 pa[4];
#pragma unroll
                for (int s = 0; s < 2; ++s) {
                    v4u w0, w1;
                    w0.x = cvtpk(a0[8 * s + 0], a0[8 * s + 1]); w0.y = cvtpk(a0[8 * s + 2], a0[8 * s + 3]); w0.z = cvtpk(a0[8 * s + 4], a0[8 * s + 5]); w0.w = cvtpk(a0[8 * s + 6], a0[8 * s + 7]);
                    w1.x = cvtpk(a1[8 * s + 0], a1[8 * s + 1]); w1.y = cvtpk(a1[8 * s + 2], a1[8 * s + 3]); w1.z = cvtpk(a1[8 * s + 4], a1[8 * s + 5]); w1.w = cvtpk(a1[8 * s + 6], a1[8 * s + 7]);
                    pa[s] = __builtin_bit_cast(bf16x8, w0); pa[2 + s] = __builtin_bit_cast(bf16x8, w1);
                }
                const LAS unsigned char* vp = vb + (r32 * ATT_KROW + hi * 8) * 2;
#pragma unroll
                for (int d0 = 0; d0 < 4; ++d0)
#pragma unroll
                    for (int kst = 0; kst < 4; ++kst) {
                        const bf16x8 vf = *(const LAS bf16x8*)(vp + d0 * 32 * ATT_KROW * 2 + kst * 32);
                        o[d0] = __builtin_amdgcn_mfma_f32_32x32x16_bf16(pa[kst], vf, o[d0], 0, 0, 0);
                    }
            }
            if (t + 1 < NT) { ATT_STOREK((t + 1) & 1); ATT_STOREV((t + 1) & 1); }
            __syncthreads();
        }
        int lane_e = lane; asm volatile("" : "+v"(lane_e));
        const unsigned obase = (unsigned)(((b * SEQ + qw + 4 * (lane_e >> 5)) * DM + RW + h * 128 + (lane_e & 31)) * 2);
        float sw[4];
#pragma unroll
        for (int d0 = 0; d0 < 4; ++d0) sw[d0] = swp[d0 * 32 + (lane_e & 31)] * oscale;
#pragma unroll
        for (int r = 0; r < 16; ++r) {
            float ss = o[0][r] * o[0][r] + o[1][r] * o[1][r] + o[2][r] * o[2][r] + o[3][r] * o[3][r];
            ss += __shfl_xor(ss, 1); ss += __shfl_xor(ss, 2); ss += __shfl_xor(ss, 4); ss += __shfl_xor(ss, 8); ss += __shfl_xor(ss, 16);
            const float rs = rsqrtf(ss * (1.f / 128.f) + 1e-5f);
            unsigned char* op = (unsigned char*)MIXIN + (obase + (unsigned)(((r & 3) + 8 * (r >> 2)) * DM * 2));
#pragma unroll
            for (int d0 = 0; d0 < 4; ++d0) *(bf16*)(op + d0 * 64) = f2bf(o[d0][r] * rs * sw[d0]);
        }
#undef ATT_LOADK
#undef ATT_STOREK
#undef ATT_LOADV
#undef ATT_STOREV
    }
}


__device__ __forceinline__ void att2_qk(f32x16& s0, f32x16& s1, const LAS unsigned char* kbuf, int mp, const bf16x8 (&qf)[4], int r32, int hi, float nref) {
    s0 = (f32x16){nref, nref, nref, nref, nref, nref, nref, nref, nref, nref, nref, nref, nref, nref, nref, nref}; s1 = s0;
    const LAS unsigned char* kp = kbuf + ((mp * 64 + r32) * ATT_KROW + hi * 8) * 2;
#pragma unroll
    for (int ks = 0; ks < 4; ++ks) s0 = __builtin_amdgcn_mfma_f32_32x32x16_bf16(*(const LAS bf16x8*)(kp + ks * 32), qf[ks], s0, 0, 0, 0);
#pragma unroll
    for (int ks = 0; ks < 4; ++ks) s1 = __builtin_amdgcn_mfma_f32_32x32x16_bf16(*(const LAS bf16x8*)(kp + 32 * ATT_KROW * 2 + ks * 32), qf[ks], s1, 0, 0, 0);
}
__device__ __forceinline__ float att2_sum16(const f32x16& s) {
    return ((s[0] + s[1]) + (s[2] + s[3])) + ((s[4] + s[5]) + (s[6] + s[7])) + (((s[8] + s[9]) + (s[10] + s[11])) + ((s[12] + s[13]) + (s[14] + s[15])));
}
__device__ __forceinline__ void att2_exp(f32x16& s, bool msk, int kvh, int qa, int hi, bf16x8& pa0, bf16x8& pa1) {
    if (msk) {
#pragma unroll
        for (int r = 0; r < 16; ++r) if (kvh + crow(r, hi) > qa) s[r] = -INFINITY; }
#pragma unroll
    for (int r = 0; r < 16; ++r) s[r] = __builtin_amdgcn_exp2f(s[r]);
    v4u w0, w1;
    w0.x = cvtpk(s[0], s[1]); w0.y = cvtpk(s[2], s[3]); w0.z = cvtpk(s[4], s[5]); w0.w = cvtpk(s[6], s[7]);
    w1.x = cvtpk(s[8], s[9]); w1.y = cvtpk(s[10], s[11]); w1.z = cvtpk(s[12], s[13]); w1.w = cvtpk(s[14], s[15]);
    pa0 = __builtin_bit_cast(bf16x8, w0); pa1 = __builtin_bit_cast(bf16x8, w1);
}
constexpr int ATT2_VP = 160, ATT2_VBUF = 64 * ATT2_VP * 2;
typedef short att_s16x4 __attribute__((ext_vector_type(4)));
__device__ __forceinline__ bf16x8 att2_vtr(const LAS unsigned char* p) {
    const att_s16x4 a = __builtin_amdgcn_ds_read_tr16_b64_v4i16((LAS att_s16x4*)p), c = __builtin_amdgcn_ds_read_tr16_b64_v4i16((LAS att_s16x4*)(p + 8 * ATT2_VP * 2));
    return __builtin_shufflevector(a, c, 0, 1, 2, 3, 4, 5, 6, 7);
}
__device__ __forceinline__ void ph_attn2(KA A, const Ctx& C, int l, unsigned* queue) {
    const int tid = C.tid, lane = C.lane, wave = C.wave, r32 = lane & 31, hi = lane >> 5, g = wave >> 1, mp = wave & 1;
    const bf16* P = (const bf16*)(A->ws + WS_P); bf16* MIXIN = (bf16*)(A->ws + WS_MIXIN);
    const float* kmaxf = (const float*)(A->ws + WS_CTL) + CW_KMAX + 128 * l;
    float lam;
    { const float a1 = A->in[22][l * 64 + lane] * A->in[23][l * 64 + lane], a2 = A->in[24][l * 64 + lane] * A->in[25][l * 64 + lane];
      lam = __expf(wave_sum(a1)) - __expf(wave_sum(a2)) + lam_init_of(l); }
    const float oscale = 1.f - lam_init_of(l);
    const float* swp = A->in[26] + l * 128;
    LAS unsigned char* const kbase = C.lds; LAS unsigned char* const vbase = C.lds + 2 * ATT_KBUF;
    LAS float* const cscr = (LAS float*)(C.lds + 2 * ATT_KBUF + 2 * ATT2_VBUF) + wave * 32;
    LAS float* const xch = (LAS float*)C.lds + g * 4096 + lane;
    static_assert(4 * 4096 * 4 <= 2 * ATT_KBUF + 2 * ATT2_VBUF, "exchange area");
    const int k_kv = tid >> 4, k_part = tid & 15;
    const unsigned k_goff = (unsigned)(k_kv * PP + k_part * 8) * 2u;
    const int k_loff = (((k_part >> 3) * 64 + k_kv) * ATT_KROW + (k_part & 7) * 8) * 2;
    const int v_kv = tid >> 4, v_part = tid & 15;
    const unsigned v_goff = (unsigned)(v_kv * PP + v_part * 8) * 2u;
    const int v_loff = (v_kv * ATT2_VP + v_part * 8) * 2;
    LAS unsigned* const qslot = (LAS unsigned*)(C.lds + LDSCTL_OFF + 64);
    for (;;) {
        if (tid == 0) *qslot = __hip_atomic_fetch_add(queue, 1u, __ATOMIC_RELAXED, __HIP_MEMORY_SCOPE_AGENT);
        __syncthreads();
        const unsigned u = (unsigned)__builtin_amdgcn_readfirstlane((int)*qslot);
        __syncthreads();
        if (u >= 64u * 32u) break;
        const int bh = (int)(u >> 9) * 16 + (int)(u & 15u), qb = 31 - (int)((u >> 4) & 31u);
        const int b = bh >> 3, h = bh & 7, q0 = qb * 128, qw = q0 + 32 * g, qa = qw + r32;
        const bf16* Pb = P + (size_t)b * SEQ * PP;
        const bf16* Kg = Pb + C_KD + h * 128; const bf16* Vg = Pb + C_VD + h * 128;
        const unsigned qoff = (unsigned)(qa * PP + C_Q + h * 128 + mp * 64 + hi * 8) * 2u;
        bf16x8 qf[4];
#pragma unroll
        for (int ks = 0; ks < 4; ++ks) qf[ks] = *(const bf16x8*)((const unsigned char*)Pb + (qoff + (unsigned)(ks * 32)));
        float ref;
        { float q2 = 0.f;
#pragma unroll
          for (int ks = 0; ks < 4; ++ks) { float f[8]; unpack8(__builtin_bit_cast(v4u, qf[ks]), f);
#pragma unroll
              for (int e = 0; e < 8; ++e) q2 += f[e] * f[e]; }
          q2 += __shfl_xor(q2, 32);
          ref = sqrtf(q2 * kmaxf[b * 16 + h * 2 + mp]) * 1.02f; }
        const int NT = 2 * (qb + 1), my_nt = (qw + 31) / 64 + 1;
        v4u kreg[2], vreg[2];
#define ATT_LOADK(t) do { _Pragma("unroll") for (int i_ = 0; i_ < 2; ++i_) kreg[i_] = *(const v4u*)((const unsigned char*)Kg + (k_goff + (unsigned)(((t) * 64 + 32 * i_) * PP * 2))); } while (0)
#define ATT_STOREK(buf) do { _Pragma("unroll") for (int i_ = 0; i_ < 2; ++i_) *(LAS v4u*)(kbase + (buf) * ATT_KBUF + k_loff + i_ * 32 * ATT_KROW * 2) = kreg[i_]; } while (0)
#define ATT_LOADV(t) do { _Pragma("unroll") for (int i_ = 0; i_ < 2; ++i_) vreg[i_] = *(const v4u*)((const unsigned char*)Vg + (v_goff + (unsigned)(((t) * 64 + 32 * i_) * PP * 2))); } while (0)
#define ATT_STOREV(buf) do { _Pragma("unroll") for (int i_ = 0; i_ < 2; ++i_) *(LAS v4u*)(vbase + (buf) * ATT2_VBUF + v_loff + i_ * 32 * ATT2_VP * 2) = vreg[i_]; } while (0)
        f32x16 o[4]; float lsum = 0.f;
        const float nref = -ref;
#pragma unroll
        for (int d0 = 0; d0 < 4; ++d0) o[d0] = (f32x16){0.f, 0.f, 0.f, 0.f, 0.f, 0.f, 0.f, 0.f, 0.f, 0.f, 0.f, 0.f, 0.f, 0.f, 0.f, 0.f};
        ATT_LOADK(0); ATT_LOADV(0); ATT_STOREK(0); ATT_STOREV(0); if (NT > 1) { ATT_LOADK(1); ATT_LOADV(1); } LDS_WAIT(); __builtin_amdgcn_s_barrier(); asm volatile("" ::: "memory");
        for (int t = 0; t < NT; ++t) {
            if (t + 1 < NT) { ATT_STOREK((t + 1) & 1); ATT_STOREV((t + 1) & 1); if (t + 2 < NT) { ATT_LOADK(t + 2); ATT_LOADV(t + 2); } }
            if (t < my_nt) {
                const LAS unsigned char* kb = kbase + (t & 1) * ATT_KBUF; const LAS unsigned char* vb = vbase + (t & 1) * ATT2_VBUF; const bool msk = (t * 64 + 63 > qw);
                bf16x8 pa[4]; f32x16 s0, s1;
                const LAS unsigned char* vp = vb + ((4 * hi + ((lane & 15) >> 2)) * ATT2_VP + 16 * ((lane >> 4) & 1) + 4 * (lane & 3)) * 2;
                __builtin_amdgcn_s_setprio(1);
                const LAS unsigned char* kp = kb + ((mp * 64 + r32) * ATT_KROW + hi * 8) * 2;
                bf16x8 kf[8];
#pragma unroll
                for (int ks = 0; ks < 4; ++ks) { kf[ks] = *(const LAS bf16x8*)(kp + ks * 32); kf[4 + ks] = *(const LAS bf16x8*)(kp + 32 * ATT_KROW * 2 + ks * 32); }
                __builtin_amdgcn_sched_barrier(0);
                s0 = (f32x16){nref, nref, nref, nref, nref, nref, nref, nref, nref, nref, nref, nref, nref, nref, nref, nref}; s1 = s0;
#pragma unroll
                for (int ks = 0; ks < 4; ++ks) s0 = __builtin_amdgcn_mfma_f32_32x32x16_bf16(kf[ks], qf[ks], s0, 0, 0, 0);
#pragma unroll
                for (int ks = 0; ks < 4; ++ks) s1 = __builtin_amdgcn_mfma_f32_32x32x16_bf16(kf[4 + ks], qf[ks], s1, 0, 0, 0);
                bf16x8 vf[8];
#pragma unroll
                for (int d0 = 0; d0 < 4; ++d0)
#pragma unroll
                    for (int kst = 0; kst < 2; ++kst) vf[d0 * 2 + kst] = att2_vtr(vp + (16 * kst * ATT2_VP + d0 * 32) * 2);
                __builtin_amdgcn_sched_barrier(0);
                att2_exp(s0, msk, t * 64, qa, hi, pa[0], pa[1]);
                lsum += att2_sum16(s0);
#pragma unroll
                for (int d0 = 0; d0 < 4; ++d0)
#pragma unroll
                    for (int kst = 0; kst < 2; ++kst) o[d0] = __builtin_amdgcn_mfma_f32_32x32x16_bf16(pa[kst], vf[d0 * 2 + kst], o[d0], 0, 0, 0);
                __builtin_amdgcn_sched_barrier(0);
                bf16x8 vg[8];
#pragma unroll
                for (int d0 = 0; d0 < 4; ++d0)
#pragma unroll
                    for (int kst = 2; kst < 4; ++kst) vg[d0 * 2 + kst - 2] = att2_vtr(vp + (16 * kst * ATT2_VP + d0 * 32) * 2);
                __builtin_amdgcn_sched_barrier(0);
                att2_exp(s1, msk, t * 64 + 32, qa, hi, pa[2], pa[3]);
                lsum += att2_sum16(s1);
#pragma unroll
                for (int d0 = 0; d0 < 4; ++d0)
#pragma unroll
                    for (int kst = 2; kst < 4; ++kst) o[d0] = __builtin_amdgcn_mfma_f32_32x32x16_bf16(pa[kst], vg[d0 * 2 + kst - 2], o[d0], 0, 0, 0);
                __builtin_amdgcn_s_setprio(0);
            }
            LDS_WAIT(); __builtin_amdgcn_s_barrier(); asm volatile("" ::: "memory");
        }
        int lane_e = lane; asm volatile("" : "+v"(lane_e));
        const float fnum = (mp == 0) ? 1.f : lam;
        lsum += __shfl_xor(lsum, 32);
        cscr[r32] = lsum; LDS_WAIT(); asm volatile("" ::: "memory");
#pragma unroll
        for (int r = 0; r < 16; ++r) { const float cf = fnum / cscr[(r & 3) + 8 * (r >> 2) + 4 * (lane_e >> 5)];
#pragma unroll
            for (int d0 = 0; d0 < 4; ++d0) o[d0][r] *= cf; }
        if (mp == 1) {
#pragma unroll
            for (int d0 = 0; d0 < 4; ++d0)
#pragma unroll
                for (int r = 0; r < 16; ++r) xch[(d0 * 16 + r) * 64] = o[d0][r];
        }
        __syncthreads();
        if (mp == 0) {
            const unsigned obase = (unsigned)(((b * SEQ + qw + 4 * (lane_e >> 5)) * DM + RW + h * 128 + (lane_e & 31)) * 2);
            float sw[4];
#pragma unroll
            for (int d0 = 0; d0 < 4; ++d0) sw[d0] = swp[d0 * 32 + (lane_e & 31)] * oscale;
#pragma unroll
            for (int r = 0; r < 16; ++r) {
                float ov[4]; float ss = 0.f;
#pragma unroll
                for (int d0 = 0; d0 < 4; ++d0) { ov[d0] = o[d0][r] - xch[(d0 * 16 + r) * 64]; ss += ov[d0] * ov[d0]; }
                ss += __shfl_xor(ss, 1); ss += __shfl_xor(ss, 2); ss += __shfl_xor(ss, 4); ss += __shfl_xor(ss, 8); ss += __shfl_xor(ss, 16);
                const float rs = rsqrtf(ss * (1.f / 128.f) + 1e-5f);
                unsigned char* op = (unsigned char*)MIXIN + (obase + (unsigned)(((r & 3) + 8 * (r >> 2)) * DM * 2));
#pragma unroll
                for (int d0 = 0; d0 < 4; ++d0) *(bf16*)(op + d0 * 64) = f2bf(ov[d0] * rs * sw[d0]);
            }
        }
        __syncthreads();
#undef ATT_LOADK
#undef ATT_STOREK
#undef ATT_LOADV
#undef ATT_STOREV
    }
}
#ifdef NAIVE_ATTN
__device__ __forceinline__ void ph_attn_naive(KA A, const Ctx& C, int l) {
    const int lane = C.lane;
    const bf16* P = (const bf16*)(A->ws + WS_P); bf16* MIXIN = (bf16*)(A->ws + WS_MIXIN);
    float lam;
    { const float a1 = A->in[22][l * 64 + lane] * A->in[23][l * 64 + lane], a2 = A->in[24][l * 64 + lane] * A->in[25][l * 64 + lane];
      lam = __expf(wave_sum(a1)) - __expf(wave_sum(a2)) + lam_init_of(l); }
    const float oscale = 1.f - lam_init_of(l);
    const float sw0 = A->in[26][l * 128 + lane] * oscale, sw1 = A->in[26][l * 128 + 64 + lane] * oscale;
    LAS float* qs = (LAS float*)(C.lds + C.wave * 1024);
    for (int it = C.gw; it < M * 8; it += C.NGW) {
        const int m = it >> 3, h = it & 7, b = m >> 12, t = m & (SEQ - 1);
        const bf16* Pb = P + (size_t)b * SEQ * PP;
        const bf16* qp = Pb + (size_t)t * PP + C_Q + h * 128;
        qs[lane] = bf2f(qp[lane]); qs[64 + lane] = bf2f(qp[64 + lane]);
        LDS_WAIT(); asm volatile("" ::: "memory");
        float m1 = -INFINITY, l1 = 0.f, m2 = -INFINITY, l2 = 0.f;
        for (int kv = lane; kv <= t; kv += 64) {
            const bf16* kp = Pb + (size_t)kv * PP + C_KD + h * 128; float s1 = 0.f, s2 = 0.f;
#pragma unroll 4
            for (int d8 = 0; d8 < 8; ++d8) { float k1[8], k2[8]; unpack8(*(const v4u*)(kp + d8 * 8), k1); unpack8(*(const v4u*)(kp + 64 + d8 * 8), k2);
#pragma unroll
                for (int e = 0; e < 8; ++e) { s1 += qs[d8 * 8 + e] * k1[e]; s2 += qs[64 + d8 * 8 + e] * k2[e]; } }
            float mn = fmaxf(m1, s1); l1 = l1 * __builtin_amdgcn_exp2f(m1 - mn) + __builtin_amdgcn_exp2f(s1 - mn); m1 = mn;
            mn = fmaxf(m2, s2); l2 = l2 * __builtin_amdgcn_exp2f(m2 - mn) + __builtin_amdgcn_exp2f(s2 - mn); m2 = mn;
        }
        float M1 = m1, M2 = m2;
#pragma unroll
        for (int o = 1; o < 64; o <<= 1) { M1 = fmaxf(M1, __shfl_xor(M1, o)); M2 = fmaxf(M2, __shfl_xor(M2, o)); }
        const float L1 = wave_sum(l1 * __builtin_amdgcn_exp2f(m1 - M1)), L2 = wave_sum(l2 * __builtin_amdgcn_exp2f(m2 - M2));
        const float c1 = 1.f / L1, c2 = lam / L2;
        float o0 = 0.f, o1 = 0.f;
        for (int kv0 = 0; kv0 <= t; kv0 += 64) {
            const int kv = kv0 + lane; float pt = 0.f;
            if (kv <= t) {
                const bf16* kp = Pb + (size_t)kv * PP + C_KD + h * 128; float s1 = 0.f, s2 = 0.f;
#pragma unroll 4
                for (int d8 = 0; d8 < 8; ++d8) { float k1[8], k2[8]; unpack8(*(const v4u*)(kp + d8 * 8), k1); unpack8(*(const v4u*)(kp + 64 + d8 * 8), k2);
#pragma unroll
                    for (int e = 0; e < 8; ++e) { s1 += qs[d8 * 8 + e] * k1[e]; s2 += qs[64 + d8 * 8 + e] * k2[e]; } }
                pt = __builtin_amdgcn_exp2f(s1 - M1) * c1 - __builtin_amdgcn_exp2f(s2 - M2) * c2;
            }
            const int nj = (t - kv0 + 1) < 64 ? (t - kv0 + 1) : 64;
            for (int j = 0; j < nj; ++j) { const float pj = __shfl(pt, j); const bf16* vp = Pb + (size_t)(kv0 + j) * PP + C_VD + h * 128; o0 += pj * bf2f(vp[lane]); o1 += pj * bf2f(vp[64 + lane]); }
        }
        const float rs = rsqrtf(wave_sum(o0 * o0 + o1 * o1) * (1.f / 128.f) + 1e-5f);
        bf16* op = MIXIN + (size_t)m * DM + RW + h * 128;
        op[lane] = f2bf(o0 * rs * sw0); op[64 + lane] = f2bf(o1 * rs * sw1);
        LDS_WAIT(); asm volatile("" ::: "memory");
    }
}
#endif

#ifdef NAIVE_SCAN
__device__ __forceinline__ float nv_shift(const bf16* Pm, int t, int col, float mu) { const float p = bf2f(Pm[col]); const float q = t > 0 ? bf2f(Pm[col - PP]) : 0.f; return p + mu * (q - p); }
__device__ __forceinline__ void ph_scan_naive(KA A, const Ctx& C, int l) {
    if (C.wave != 0) return;
    const int lane = C.lane;
    const bf16* P = (const bf16*)(A->ws + WS_P); bf16* VF = (bf16*)((unsigned char*)A->out + OUT_VF); bf16* MIXIN = (bf16*)(A->ws + WS_MIXIN);
    LAS float* sx = (LAS float*)C.lds;
    LAS float* sv = sx + 320;
    for (int bh = blockIdx.x; bh < BATCH * 16; bh += C.G) {
        const int b = bh >> 4, hd = bh & 15, c = hd * 64 + lane;
        const float* mu = A->in[8] + (size_t)l * 3360; const float* mumv = A->in[9] + (size_t)(l > 0 ? l - 1 : 0) * 32;
        const float* w2 = A->in[11] + (size_t)l * 64 * RW; const float* a2 = A->in[13] + (size_t)l * 64 * RW; const float* g2 = A->in[14] + (size_t)l * 160 * RW; const float* v2 = A->in[21] + (size_t)(l > 0 ? l - 1 : 0) * 32 * RW;
        const float w0c = A->in[10][l * RW + c], a0c = A->in[12][l * RW + c], kkc = A->in[15][l * RW + c], kac = A->in[16][l * RW + c], rkc = A->in[17][l * RW + c];
        const float gnw = A->in[18][l * RW + c], gnb = A->in[19][l * RW + c];
        const float v0c = l > 0 ? A->in[20][(l - 1) * RW + c] : 0.f;
        float S[64];
#pragma unroll
        for (int j = 0; j < 64; ++j) S[j] = 0.f;
        for (int t = 0; t < SEQ; ++t) {
            const size_t m = (size_t)b * SEQ + t; const bf16* Pm = P + m * PP;
            sx[lane] = tanhf(nv_shift(Pm, t, C_WL + lane, mu[C_WL + lane]));
            sx[64 + lane] = nv_shift(Pm, t, C_AL + lane, mu[C_AL + lane]);
            sx[128 + lane] = 1.f / (1.f + expf(-nv_shift(Pm, t, C_GL + lane, mu[C_GL + lane])));
            sx[192 + lane] = 1.f / (1.f + expf(-nv_shift(Pm, t, C_GL + 64 + lane, mu[C_GL + 64 + lane])));
            if (lane < 32) { sx[256 + lane] = 1.f / (1.f + expf(-nv_shift(Pm, t, C_GL + 128 + lane, mu[C_GL + 128 + lane]))); sx[288 + lane] = l > 0 ? nv_shift(Pm, t, C_MV + lane, mumv[lane]) : 0.f; }
            LDS_WAIT(); asm volatile("" ::: "memory");
            float d = w0c, ap = a0c, g = 0.f, vgp = v0c;
#ifdef NAIVE_SCAN_USE_LO
            { const bf16* Lm = (const bf16*)(A->ws + WS_LO) + m * LON; d += bf2f(Lm[c]); ap += bf2f(Lm[RW + c]); g = bf2f(Lm[2 * RW + c]); vgp += bf2f(Lm[3 * RW + c]); }
#else
#pragma unroll 2
            for (int k = 0; k < 64; ++k) { d += sx[k] * w2[(size_t)k * RW + c]; ap += sx[64 + k] * a2[(size_t)k * RW + c]; }
#pragma unroll 2
            for (int k = 0; k < 160; ++k) g += sx[128 + k] * g2[(size_t)k * RW + c];
            if (l > 0) {
#pragma unroll 2
                for (int k = 0; k < 32; ++k) vgp += sx[288 + k] * v2[(size_t)k * RW + c]; }
#endif
            const float r = nv_shift(Pm, t, C_R + c, mu[C_R + c]), k = nv_shift(Pm, t, C_K + c, mu[C_K + c]); float v = nv_shift(Pm, t, C_V + c, mu[C_V + c]);
            const float sp = (-d > 20.f) ? -d : log1pf(expf(-d)); const float w = expf(-expf(-sp - 0.5f));
            const float a = 1.f / (1.f + expf(-ap));
            if (l > 0) { const float vf = bf2f(VF[m * RW + c]); v = v + (vf - v) * (1.f / (1.f + expf(-vgp))); } else VF[m * RW + c] = f2bf(v);
            const float kkr = k * kkc; const float kk = kkr / fmaxf(sqrtf(wave_sum(kkr * kkr)), 1e-12f);
            const float kp = k * (1.f + (a - 1.f) * kac);
            const float bc = wave_sum(r * kp * rkc);
            sv[lane] = w; sv[64 + lane] = kk; sv[128 + lane] = kk * a; sv[192 + lane] = kp; sv[256 + lane] = r;
            LDS_WAIT(); asm volatile("" ::: "memory");
            float sa = 0.f;
#pragma unroll
            for (int j = 0; j < 64; ++j) { sa += S[j] * sv[64 + j]; if ((j & 7) == 7) asm volatile("" ::: "memory"); }
            sa = -sa;
            float ov = 0.f;
#pragma unroll
            for (int j = 0; j < 64; ++j) { S[j] = S[j] * sv[j] + sa * sv[128 + j] + v * sv[192 + j]; ov += S[j] * sv[256 + j]; if ((j & 3) == 3) asm volatile("" ::: "memory"); }
            const float mean = wave_sum(ov) * (1.f / 64.f); const float dv = ov - mean; const float var = wave_sum(dv * dv) * (1.f / 64.f);
            float y = dv * rsqrtf(var + 64e-5f) * gnw + gnb;
            y = (y + bc * v) * g;
            MIXIN[m * DM + c] = f2bf(y);
            LDS_WAIT(); asm volatile("" ::: "memory");
        }
    }
}
#endif

#ifdef NAIVE_LORA
#ifdef NAIVE_LORA_RND
#define NVR(x) bf2f(f2bf(x))
#else
#define NVR(x) (x)
#endif
__device__ __forceinline__ void ph_lora_naive(KA A, const Ctx& C, int l) {
    const bf16* LA = (const bf16*)(A->ws + WS_LA); bf16* LO = (bf16*)(A->ws + WS_LO);
    const float* w2 = A->in[11] + (size_t)l * 64 * RW; const float* a2 = A->in[13] + (size_t)l * 64 * RW; const float* g2 = A->in[14] + (size_t)l * 160 * RW; const float* v2 = A->in[21] + (size_t)(l > 0 ? l - 1 : 0) * 32 * RW;
    for (int m = blockIdx.x; m < M; m += C.G) {
        const bf16* La = LA + (size_t)m * LAK;
        for (int n = C.tid; n < LON; n += NWAVES * 64) {
            const int blk = n >> 10, nn = n & 1023; float acc = 0.f;
#ifdef NAIVE_LORA_USE_WL
            { const bf16* Wn = (const bf16*)(A->ws + WS_WL) + (size_t)n * LAK; for (int k = 0; k < LAK; ++k) acc += bf2f(La[k]) * bf2f(Wn[k]); }
            if (true) {}
            else if (blk == 0)
#else
            if (blk == 0)
#endif
            { for (int k = 0; k < 64; ++k) acc += bf2f(La[k]) * NVR(w2[(size_t)k * RW + nn]); }
            else if (blk == 1) { for (int k = 0; k < 64; ++k) acc += bf2f(La[64 + k]) * NVR(a2[(size_t)k * RW + nn]); }
            else if (blk == 2) { for (int k = 0; k < 160; ++k) acc += bf2f(La[128 + k]) * NVR(g2[(size_t)k * RW + nn]); }
            else if (l > 0) { for (int k = 0; k < 32; ++k) acc += bf2f(La[288 + k]) * NVR(v2[(size_t)k * RW + nn]); }
            LO[(size_t)m * LON + n] = f2bf(acc);
        }
    }
}
#endif
__device__ __forceinline__ float red8(float x) { x += DPPF(x, 0xB1); x += DPPF(x, 0x4E); x += DPPF(x, 0x141); return x; }
constexpr int SC_T = 32;
__device__ __forceinline__ void ph_scan(KA A, const Ctx& C, int l) {
    const int lane = C.lane, wave = C.wave;
    const bf16* P = (const bf16*)(A->ws + WS_P); const bf16* LO = (const bf16*)(A->ws + WS_LO); bf16* VF = (bf16*)((unsigned char*)A->out + OUT_VF); bf16* MIXIN = (bf16*)(A->ws + WS_MIXIN);
    LAS float* sW = (LAS float*)C.lds; LAS float* sKK = sW + SC_T * 64; LAS float* sBB = sKK + SC_T * 64; LAS float* sKP = sBB + SC_T * 64; LAS float* sR = sKP + SC_T * 64;
    LAS float* sV = sR + SC_T * 64; LAS float* sG = sV + SC_T * 64; LAS float* sO = sG + SC_T * 64; LAS float* sBC = sO + SC_T * 64;
    const int il = lane >> 3, jg = lane & 7, irow = wave * 8 + il;
    for (int bh = blockIdx.x; bh < BATCH * 16; bh += C.G) {
        const int b = bh >> 4, hd = bh & 15, c = hd * 64 + lane;
        const float* mu = A->in[8] + (size_t)l * 3360;
        const float mu_r = mu[C_R + c], mu_k = mu[C_K + c], mu_v = mu[C_V + c];
        const float w0c = A->in[10][l * RW + c], a0c = A->in[12][l * RW + c], kkc = A->in[15][l * RW + c], kac = A->in[16][l * RW + c], rkc = A->in[17][l * RW + c];
        const float gnw = A->in[18][l * RW + c], gnb = A->in[19][l * RW + c];
        const float v0c = l > 0 ? A->in[20][(l - 1) * RW + c] : 0.f;
        float S[8];
#pragma unroll
        for (int e = 0; e < 8; ++e) S[e] = 0.f;
        for (int ch = 0; ch < SEQ / SC_T; ++ch) {
#pragma unroll 1
            for (int s = 0; s < SC_T / 8; ++s) {
                const int tl = wave * (SC_T / 8) + s, t = ch * SC_T + tl; const size_t m = (size_t)b * SEQ + t;
                const bf16* Pm = P + m * PP;
                const float pr = bf2f(Pm[C_R + c]), pk = bf2f(Pm[C_K + c]), pv = bf2f(Pm[C_V + c]);
                float qr = 0.f, qk = 0.f, qv = 0.f;
                if (t > 0) { qr = bf2f(Pm[C_R + c - PP]); qk = bf2f(Pm[C_K + c - PP]); qv = bf2f(Pm[C_V + c - PP]); }
                const float r = pr + mu_r * (qr - pr), k = pk + mu_k * (qk - pk); float v = pv + mu_v * (qv - pv);
                const bf16* Lm = LO + m * LON;
                const float d = w0c + bf2f(Lm[c]);
                const float w = __expf(-0.6065306597126334f * sigmoidf_(d));
                const float a = sigmoidf_(a0c + bf2f(Lm[RW + c]));
                const float g = bf2f(Lm[2 * RW + c]);
                if (l > 0) { const float vf = bf2f(VF[m * RW + c]); const float vg = sigmoidf_(v0c + bf2f(Lm[3 * RW + c])); v = v + (vf - v) * vg; }
                else VF[m * RW + c] = f2bf(v);
                const float kkr = k * kkc; const float n2 = wave_sum(kkr * kkr); const float kk = kkr / fmaxf(sqrtf(n2), 1e-12f);
                const float kp = k * (1.f + (a - 1.f) * kac);
                const float bc = wave_sum(r * kp * rkc);
                sW[tl * 64 + lane] = w; sKK[tl * 64 + lane] = kk; sBB[tl * 64 + lane] = kk * a; sKP[tl * 64 + lane] = kp; sR[tl * 64 + lane] = r; sV[tl * 64 + lane] = v; sG[tl * 64 + lane] = g;
                if (lane == 0) sBC[tl] = bc;
            }
            __syncthreads();
#pragma unroll 2
            for (int tl = 0; tl < SC_T; ++tl) {
                const int o8 = tl * 64 + jg * 8;
                const f32x4 w0 = *(const LAS f32x4*)(sW + o8), w1 = *(const LAS f32x4*)(sW + o8 + 4), k0 = *(const LAS f32x4*)(sKK + o8), k1 = *(const LAS f32x4*)(sKK + o8 + 4);
                const f32x4 b0 = *(const LAS f32x4*)(sBB + o8), b1 = *(const LAS f32x4*)(sBB + o8 + 4), p0 = *(const LAS f32x4*)(sKP + o8), p1 = *(const LAS f32x4*)(sKP + o8 + 4);
                const f32x4 r0 = *(const LAS f32x4*)(sR + o8), r1 = *(const LAS f32x4*)(sR + o8 + 4);
                const float vi = sV[tl * 64 + irow];
                float sa = (S[0] * k0.x + S[1] * k0.y) + (S[2] * k0.z + S[3] * k0.w) + (S[4] * k1.x + S[5] * k1.y) + (S[6] * k1.z + S[7] * k1.w);
                sa = -red8(sa);
                S[0] = S[0] * w0.x + sa * b0.x + vi * p0.x; S[1] = S[1] * w0.y + sa * b0.y + vi * p0.y; S[2] = S[2] * w0.z + sa * b0.z + vi * p0.z; S[3] = S[3] * w0.w + sa * b0.w + vi * p0.w;
                S[4] = S[4] * w1.x + sa * b1.x + vi * p1.x; S[5] = S[5] * w1.y + sa * b1.y + vi * p1.y; S[6] = S[6] * w1.z + sa * b1.z + vi * p1.z; S[7] = S[7] * w1.w + sa * b1.w + vi * p1.w;
                float ov = (S[0] * r0.x + S[1] * r0.y) + (S[2] * r0.z + S[3] * r0.w) + (S[4] * r1.x + S[5] * r1.y) + (S[6] * r1.z + S[7] * r1.w);
                ov = red8(ov);
                if (jg == 0) sO[tl * 64 + irow] = ov;
            }
            __syncthreads();
#pragma unroll 1
            for (int s = 0; s < SC_T / 8; ++s) {
                const int tl = wave * (SC_T / 8) + s, t = ch * SC_T + tl; const size_t m = (size_t)b * SEQ + t;
                const float ov = sO[tl * 64 + lane]; const float mean = wave_sum(ov) * (1.f / 64.f); const float dv = ov - mean; const float var = wave_sum(dv * dv) * (1.f / 64.f);
                float y = dv * rsqrtf(var + 64e-5f) * gnw + gnb;
                y = (y + sBC[tl] * sV[tl * 64 + lane]) * sG[tl * 64 + lane];
                MIXIN[m * DM + c] = f2bf(y);
            }
            __syncthreads();
        }
    }
}


__device__ __forceinline__ float wave_sum_dpp(float x) {
    x += DPPF(x, 0xB1); x += DPPF(x, 0x4E); x += DPPF(x, 0x141); x += DPPF(x, 0x140);
    const int xi = __float_as_int(x);
    const float s0 = __int_as_float(__builtin_amdgcn_readlane(xi, 0)), s1 = __int_as_float(__builtin_amdgcn_readlane(xi, 16)), s2 = __int_as_float(__builtin_amdgcn_readlane(xi, 32)), s3 = __int_as_float(__builtin_amdgcn_readlane(xi, 48));
    return (s0 + s1) + (s2 + s3);
}
constexpr int SC2_T = 16, SC2_NC = SEQ / SC2_T, SC2_VEC = SC2_T * 64;
constexpr int SC2_IN_B = 5 * SC2_VEC * 2 + SC2_VEC * 4, SC2_OUT_B = SC2_VEC * 4, SC2_GG_B = 2 * SC2_VEC * 4;
typedef _Float16 h2_t __attribute__((ext_vector_type(2)));
typedef _Float16 h4_t __attribute__((ext_vector_type(4)));
typedef _Float16 h8_t __attribute__((ext_vector_type(8)));
constexpr int SC2_OFF_IN = 0, SC2_OFF_OUT = 2 * SC2_IN_B, SC2_OFF_GG = SC2_OFF_OUT + 2 * SC2_OUT_B;
static_assert(SC2_OFF_GG + 3 * SC2_GG_B <= RING_BYTES && (SC2_IN_B % 16) == 0, "scan LDS map");
__device__ __forceinline__ float row16_sum(float x) { x += DPPF(x, 0xB1); x += DPPF(x, 0x4E); x += DPPF(x, 0x141); x += DPPF(x, 0x140); return x; }

struct Sc2In { h8_t u0, u1, k0, k1, b0, b1, q0, q1, x0, x1; float vv; };
__device__ __forceinline__ void sc2_read(Sc2In& X, const LAS unsigned char* in, int t, int cq, int irow) {
    const LAS _Float16* p = (const LAS _Float16*)in + t * 64 + cq * 16;
    X.u0 = *(const LAS h8_t*)(p); X.u1 = *(const LAS h8_t*)(p + 8); X.k0 = *(const LAS h8_t*)(p + SC2_VEC); X.k1 = *(const LAS h8_t*)(p + SC2_VEC + 8);
    X.b0 = *(const LAS h8_t*)(p + 2 * SC2_VEC); X.b1 = *(const LAS h8_t*)(p + 2 * SC2_VEC + 8); X.q0 = *(const LAS h8_t*)(p + 3 * SC2_VEC); X.q1 = *(const LAS h8_t*)(p + 3 * SC2_VEC + 8);
    X.x0 = *(const LAS h8_t*)(p + 4 * SC2_VEC); X.x1 = *(const LAS h8_t*)(p + 4 * SC2_VEC + 8);
    X.vv = *((const LAS float*)(in + 5 * SC2_VEC * 2) + t * 64 + irow);
}
#define H2AT(v, e) ((h2_t){(v)[2 * (e)], (v)[2 * (e) + 1]})
__device__ __forceinline__ float quad_sum(float x) { x += DPPF(x, 0xB1); x += DPPF(x, 0x4E); return x; }
__device__ __forceinline__ void sc2_step(h2_t (&S)[8], const Sc2In& X, LAS float* out, int t, int cq, int irow) {
    float a0 = 0.f, a1 = 0.f;
#pragma unroll
    for (int e = 0; e < 4; ++e) { a0 = __builtin_amdgcn_fdot2(S[e], H2AT(X.k0, e), a0, false); a1 = __builtin_amdgcn_fdot2(S[4 + e], H2AT(X.k1, e), a1, false); }
    const float sa = -quad_sum(a0 + a1);
    const h2_t sav = {(_Float16)sa, (_Float16)sa}, vv2 = {(_Float16)X.vv, (_Float16)X.vv};
#pragma unroll
    for (int e = 0; e < 4; ++e) {
        S[e] = ((S[e] - S[e] * H2AT(X.u0, e)) + vv2 * H2AT(X.q0, e)) + sav * H2AT(X.b0, e);
        S[4 + e] = ((S[4 + e] - S[4 + e] * H2AT(X.u1, e)) + vv2 * H2AT(X.q1, e)) + sav * H2AT(X.b1, e); }
    float o0 = 0.f, o1 = 0.f;
#pragma unroll
    for (int e = 0; e < 4; ++e) { o0 = __builtin_amdgcn_fdot2(S[e], H2AT(X.x0, e), o0, false); o1 = __builtin_amdgcn_fdot2(S[4 + e], H2AT(X.x1, e), o1, false); }
    const float oo = quad_sum(o0 + o1);
    if (cq == 0) out[t * 64 + irow] = oo;
}
__device__ __forceinline__ void scan2_scanner(LAS unsigned char* lds, int wave, int lane) {
    const int cq = lane & 3, irow = wave * 16 + (lane >> 2);
    h2_t S[8];
#pragma unroll
    for (int e = 0; e < 8; ++e) S[e] = (h2_t){(_Float16)0.f, (_Float16)0.f};
    __syncthreads();
    for (int c = 0; c < SC2_NC; ++c) {
        const LAS unsigned char* in = lds + SC2_OFF_IN + (c & 1) * SC2_IN_B;
        LAS float* out = (LAS float*)(lds + SC2_OFF_OUT + (c & 1) * SC2_OUT_B);
        Sc2In XA, XB;
        sc2_read(XA, in, 0, cq, irow);
#pragma unroll 2
        for (int t = 0; t < SC2_T; t += 2) {
            sc2_read(XB, in, t + 1, cq, irow);
            sc2_step(S, XA, out, t, cq, irow);
            if (t + 2 < SC2_T) sc2_read(XA, in, t + 2, cq, irow);
            sc2_step(S, XB, out, t + 1, cq, irow);
        }
        __syncthreads();
    }
}

__device__ __forceinline__ f32x4 up4(const v2u v) { return (f32x4){bf_lo(v.x), bf_hi(v.x), bf_lo(v.y), bf_hi(v.y)}; }
struct Sc2Raw { v2u pr, pk, pv, qr, qk, qv, ld, la, lg, lv, vf; };
struct Sc2Par { f32x4 mu_r, mu_k, mu_v, w0c, a0c, kkc, kac, rkc, gnw, gnb, v0c; const unsigned char* P; const unsigned char* LO; unsigned char* VF; unsigned char* MIXIN; unsigned mb, offP; int tl, q4, l; };
__device__ __forceinline__ void sc2_load(Sc2Raw& R, const Sc2Par& p, int c) {
    const unsigned m = p.mb + (unsigned)(c * SC2_T) + (unsigned)p.tl; const unsigned char* Pm = p.P + (size_t)m * (PP * 2); const unsigned char* Lm = p.LO + (size_t)m * (LON * 2);
    const v2u zero2 = {0u, 0u};
    R.pr = __builtin_nontemporal_load((const v2u*)(Pm + C_R * 2 + p.offP)); R.pk = __builtin_nontemporal_load((const v2u*)(Pm + C_K * 2 + p.offP)); R.pv = __builtin_nontemporal_load((const v2u*)(Pm + C_V * 2 + p.offP));
    if (c * SC2_T + p.tl > 0) { R.qr = __builtin_nontemporal_load((const v2u*)(Pm - PP * 2 + C_R * 2 + p.offP)); R.qk = __builtin_nontemporal_load((const v2u*)(Pm - PP * 2 + C_K * 2 + p.offP)); R.qv = __builtin_nontemporal_load((const v2u*)(Pm - PP * 2 + C_V * 2 + p.offP)); } else { R.qr = zero2; R.qk = zero2; R.qv = zero2; }
    R.ld = __builtin_nontemporal_load((const v2u*)(Lm + p.offP)); R.la = __builtin_nontemporal_load((const v2u*)(Lm + RW * 2 + p.offP)); R.lg = __builtin_nontemporal_load((const v2u*)(Lm + 2 * RW * 2 + p.offP)); R.lv = __builtin_nontemporal_load((const v2u*)(Lm + 3 * RW * 2 + p.offP));
    R.vf = (p.l > 0) ? __builtin_nontemporal_load((const v2u*)(p.VF + (size_t)m * (RW * 2) + p.offP)) : zero2;
}
__device__ __forceinline__ void sc2_stage(const Sc2Raw& R, const Sc2Par& p, LAS unsigned char* lds, int c, int gi) {
    LAS _Float16* inh = (LAS _Float16*)(lds + SC2_OFF_IN + (c & 1) * SC2_IN_B) + p.tl * 64 + p.q4; LAS float* inv = (LAS float*)(lds + SC2_OFF_IN + (c & 1) * SC2_IN_B + 5 * SC2_VEC * 2) + p.tl * 64 + p.q4;
    LAS float* gg = (LAS float*)(lds + SC2_OFF_GG + gi * SC2_GG_B) + p.tl * 64 + p.q4;
    const f32x4 cr = up4(R.pr), ck = up4(R.pk), cv = up4(R.pv);
    const f32x4 r = cr + p.mu_r * (up4(R.qr) - cr), k = ck + p.mu_k * (up4(R.qk) - ck); f32x4 v = cv + p.mu_v * (up4(R.qv) - cv);
    const f32x4 d = p.w0c + up4(R.ld), ap = p.a0c + up4(R.la), g = up4(R.lg); f32x4 w, a;
#pragma unroll
    for (int e = 0; e < 4; ++e) { w[e] = 1.f - __expf(-0.6065306597126334f * sigmoidf_(d[e])); a[e] = sigmoidf_(ap[e]); }
    if (p.l > 0) { const f32x4 vg = p.v0c + up4(R.lv), vf = up4(R.vf);
#pragma unroll
        for (int e = 0; e < 4; ++e) v[e] = v[e] + (vf[e] - v[e]) * sigmoidf_(vg[e]); }
    else { v2u o; o.x = cvtpk(v[0], v[1]); o.y = cvtpk(v[2], v[3]); *(v2u*)(p.VF + (size_t)(p.mb + (unsigned)(c * SC2_T) + (unsigned)p.tl) * (RW * 2) + p.offP) = o; }
    const f32x4 kkr = k * p.kkc; const float n2 = row16_sum((kkr[0] * kkr[0] + kkr[1] * kkr[1]) + (kkr[2] * kkr[2] + kkr[3] * kkr[3]));
    const f32x4 kk = kkr * __builtin_amdgcn_rsqf(fmaxf(n2, 1e-24f)); const f32x4 kp = k * (1.f + (a - 1.f) * p.kac); const f32x4 rk = r * kp * p.rkc;
    const float bc = row16_sum((rk[0] + rk[1]) + (rk[2] + rk[3]));
    const f32x4 bb = kk * a;
    *(LAS h4_t*)(inh) = __builtin_convertvector(w, h4_t); *(LAS h4_t*)(inh + SC2_VEC) = __builtin_convertvector(kk, h4_t); *(LAS h4_t*)(inh + 2 * SC2_VEC) = __builtin_convertvector(bb, h4_t);
    *(LAS h4_t*)(inh + 3 * SC2_VEC) = __builtin_convertvector(kp, h4_t); *(LAS h4_t*)(inh + 4 * SC2_VEC) = __builtin_convertvector(r, h4_t); *(LAS f32x4*)(inv) = v;
    *(LAS f32x4*)(gg) = p.gnw * g; *(LAS f32x4*)(gg + SC2_VEC) = (p.gnb + bc * v) * g;
}
__device__ __forceinline__ void sc2_post(const Sc2Par& p, LAS unsigned char* lds, int c, int gi) {
    const LAS float* out = (const LAS float*)(lds + SC2_OFF_OUT + (c & 1) * SC2_OUT_B) + p.tl * 64 + p.q4; const LAS float* gg = (const LAS float*)(lds + SC2_OFF_GG + gi * SC2_GG_B) + p.tl * 64 + p.q4;
    const f32x4 o = *(const LAS f32x4*)(out); const float s1 = row16_sum((o[0] + o[1]) + (o[2] + o[3])), s2 = row16_sum((o[0] * o[0] + o[1] * o[1]) + (o[2] * o[2] + o[3] * o[3]));
    const float mean = s1 * (1.f / 64.f); const float rs = __builtin_amdgcn_rsqf(fmaxf(s2 * (1.f / 64.f) - mean * mean, 0.f) + 64e-5f);
    const f32x4 y = (o - mean) * rs * *(const LAS f32x4*)(gg) + *(const LAS f32x4*)(gg + SC2_VEC); v2u w2; w2.x = cvtpk(y[0], y[1]); w2.y = cvtpk(y[2], y[3]);
    *(v2u*)(p.MIXIN + (size_t)(p.mb + (unsigned)(c * SC2_T) + (unsigned)p.tl) * (DM * 2) + p.offP) = w2;
}
__device__ __forceinline__ void scan2_stager(KA A, LAS unsigned char* lds, int sw, int lane, int l, int b, int hd) {
    Sc2Par p;
    p.P = (const unsigned char*)(A->ws + WS_P); p.LO = (const unsigned char*)(A->ws + WS_LO); p.VF = (unsigned char*)((unsigned char*)A->out + OUT_VF); p.MIXIN = (unsigned char*)(A->ws + WS_MIXIN);
    const int st = lane >> 4; p.q4 = (lane & 15) * 4; const int cc = hd * 64 + p.q4; p.tl = 4 * sw + st; p.l = l;
    const float* mu = A->in[8] + (size_t)l * 3360;
    p.mu_r = *(const f32x4*)(mu + C_R + cc); p.mu_k = *(const f32x4*)(mu + C_K + cc); p.mu_v = *(const f32x4*)(mu + C_V + cc);
    p.w0c = *(const f32x4*)(A->in[10] + l * RW + cc); p.a0c = *(const f32x4*)(A->in[12] + l * RW + cc); p.kkc = *(const f32x4*)(A->in[15] + l * RW + cc); p.kac = *(const f32x4*)(A->in[16] + l * RW + cc);
    p.rkc = *(const f32x4*)(A->in[17] + l * RW + cc); p.gnw = *(const f32x4*)(A->in[18] + l * RW + cc); p.gnb = *(const f32x4*)(A->in[19] + l * RW + cc);
    p.v0c = l > 0 ? *(const f32x4*)(A->in[20] + (l - 1) * RW + cc) : (f32x4){0.f, 0.f, 0.f, 0.f};
    p.mb = (unsigned)b * SEQ; p.offP = (unsigned)cc * 2u;
    Sc2Raw R0, R1, R2;
    sc2_load(R0, p, 0); sc2_load(R1, p, 1); sc2_load(R2, p, 2);
    sc2_stage(R0, p, lds, 0, 0); sc2_load(R0, p, 3);
    __syncthreads();
#define SC2_BODY(ci, RN, sn, sp) do { if ((ci) < SC2_NC) { if ((ci) + 1 < SC2_NC) sc2_stage(RN, p, lds, (ci) + 1, sn); if ((ci) + 4 < SC2_NC) sc2_load(RN, p, (ci) + 4); if ((ci) >= 1) sc2_post(p, lds, (ci) - 1, sp); __syncthreads(); } } while (0)
    for (int c = 0; c < SC2_NC; c += 3) { SC2_BODY(c, R1, 1, 2); SC2_BODY(c + 1, R2, 2, 0); SC2_BODY(c + 2, R0, 0, 1); }
#undef SC2_BODY
    sc2_post(p, lds, SC2_NC - 1, (SC2_NC - 1) % 3);
}


constexpr int S3_AR = 0, S3_BK = 4608, S3_BKT = 9216, S3_UVT = 14336, S3_PC = 19456, S3_SET = 19712;
constexpr int S3_OFF_LW = 2 * S3_SET, S3_OFF_LM = S3_OFF_LW + 2 * 4096, S3_OFF_GS = S3_OFF_LM + 4608, S3_OFF_OUT = S3_OFF_GS + 8192, S3_OFF_GG = S3_OFF_OUT + 2 * SC2_OUT_B, S3_OFF_LMB = S3_OFF_GG + 4 * SC2_GG_B;
static_assert(S3_OFF_LMB + 2560 <= RING_BYTES && (S3_OFF_LW % 16) == 0 && (S3_OFF_LM % 16) == 0 && (S3_OFF_LMB % 16) == 0, "chunked scan LDS map");
struct Sc3Keep { f32x4 lw, cw, kk, bb, kp, r, v; };
__device__ __forceinline__ v2u pk4(const f32x4 x) { v2u o; o.x = cvtpk(x[0], x[1]); o.y = cvtpk(x[2], x[3]); return o; }
__device__ __forceinline__ void sc3_phaseA(const Sc2Raw& R, const Sc2Par& p, LAS unsigned char* lds, int c, int gi, Sc3Keep& K) {
    LAS float* gg = (LAS float*)(lds + S3_OFF_GG + gi * SC2_GG_B) + p.tl * 64 + p.q4;
    const f32x4 cr = up4(R.pr), ck = up4(R.pk), cv = up4(R.pv);
    const f32x4 r = cr + p.mu_r * (up4(R.qr) - cr), k = ck + p.mu_k * (up4(R.qk) - ck); f32x4 v = cv + p.mu_v * (up4(R.qv) - cv);
    const f32x4 d = p.w0c + up4(R.ld), ap = p.a0c + up4(R.la), g = up4(R.lg); f32x4 lw, a;
#pragma unroll
    for (int e = 0; e < 4; ++e) { lw[e] = (-0.6065306597126334f * 1.4426950408889634f) * sigmoidf_(d[e]); a[e] = sigmoidf_(ap[e]); }
    LAS float* const lwrow = (LAS float*)(lds + S3_OFF_LW + (c & 1) * 4096) + p.q4;
    *(LAS f32x4*)(lwrow + p.tl * 64) = lw;
    if (p.l > 0) { const f32x4 vg = p.v0c + up4(R.lv), vf = up4(R.vf);
#pragma unroll
        for (int e = 0; e < 4; ++e) v[e] = v[e] + (vf[e] - v[e]) * sigmoidf_(vg[e]); }
    else *(v2u*)(p.VF + (size_t)(p.mb + (unsigned)(c * SC2_T) + (unsigned)p.tl) * (RW * 2) + p.offP) = pk4(v);
    const f32x4 kkr = k * p.kkc; const float n2 = row16_sum((kkr[0] * kkr[0] + kkr[1] * kkr[1]) + (kkr[2] * kkr[2] + kkr[3] * kkr[3]));
    const f32x4 kk = kkr * __builtin_amdgcn_rsqf(fmaxf(n2, 1e-24f)); const f32x4 kp = k * (1.f + (a - 1.f) * p.kac); const f32x4 rk = r * kp * p.rkc;
    const float bc = row16_sum((rk[0] + rk[1]) + (rk[2] + rk[3]));
    *(LAS f32x4*)(gg) = p.gnw * g; *(LAS f32x4*)(gg + SC2_VEC) = (p.gnb + bc * v) * g;
    LDS_WAIT(); asm volatile("" ::: "memory");
    f32x4 cw = lw; const int st = p.tl & 3;
#pragma unroll
    for (int j = 0; j < 3; ++j) { const f32x4 x = *(const LAS f32x4*)(lwrow + ((p.tl & ~3) + j) * 64); if (j < st) cw += x; }
    LDS_WAIT(); asm volatile("" ::: "memory");
    *(LAS f32x4*)(lwrow + p.tl * 64) = cw;
    K.lw = lw; K.cw = cw; K.kk = kk; K.bb = kk * a; K.kp = kp; K.r = r; K.v = v;
}
__device__ __forceinline__ void sc3_phaseB(const Sc3Keep& K, const Sc2Par& p, LAS unsigned char* lds, int c) {
    const LAS float* lwp = (const LAS float*)(lds + S3_OFF_LW + (c & 1) * 4096) + p.q4; f32x4 cum = K.cw;
#pragma unroll
    for (int j = 0; j < 3; ++j) { if (4 * j + 3 < (p.tl & ~3)) cum += *(const LAS f32x4*)(lwp + (4 * j + 3) * 64); }
    f32x4 P, Pm1, iP;
#pragma unroll
    for (int e = 0; e < 4; ++e) { P[e] = __builtin_amdgcn_exp2f(cum[e]); Pm1[e] = __builtin_amdgcn_exp2f(cum[e] - K.lw[e]); iP[e] = __builtin_amdgcn_exp2f(-cum[e]); }
    const f32x4 at = Pm1 * K.kk, rt = P * K.r, bt = K.bb * iP, kt = K.kp * iP;
    LAS unsigned char* sb = lds + (c & 1) * S3_SET;
    const int tp = (p.tl & ~12) | ((p.tl & 4) << 1) | ((p.tl & 8) >> 1);
    const int qp = (p.q4 & ~12) | ((p.q4 & 4) << 1) | ((p.q4 & 8) >> 1);
    *(LAS v2u*)(sb + S3_AR + (p.tl * 72 + qp) * 2) = pk4(at); *(LAS v2u*)(sb + S3_AR + ((16 + p.tl) * 72 + qp) * 2) = pk4(rt);
    *(LAS v2u*)(sb + S3_BK + (p.tl * 72 + qp) * 2) = pk4(bt); *(LAS v2u*)(sb + S3_BK + ((16 + p.tl) * 72 + qp) * 2) = pk4(kt);
#pragma unroll
    for (int e = 0; e < 4; ++e) {
        *(LAS bf16*)(sb + S3_BKT + ((p.q4 + e) * 40 + tp) * 2) = f2bf(bt[e]); *(LAS bf16*)(sb + S3_BKT + ((p.q4 + e) * 40 + 16 + p.tl) * 2) = f2bf(kt[e]);
        *(LAS bf16*)(sb + S3_UVT + ((p.q4 + e) * 40 + 16 + p.tl) * 2) = f2bf(K.v[e]); }
    if (p.tl == SC2_T - 1) *(LAS f32x4*)((LAS float*)(sb + S3_PC) + p.q4) = P;
}
__device__ __forceinline__ void sc3_post(const Sc2Par& p, LAS unsigned char* lds, int c, int gi) {
    const LAS float* out = (const LAS float*)(lds + S3_OFF_OUT + (c & 1) * SC2_OUT_B) + p.tl * 64 + p.q4; const LAS float* gg = (const LAS float*)(lds + S3_OFF_GG + gi * SC2_GG_B) + p.tl * 64 + p.q4;
    const f32x4 o = *(const LAS f32x4*)(out); const float s1 = row16_sum((o[0] + o[1]) + (o[2] + o[3])), s2 = row16_sum((o[0] * o[0] + o[1] * o[1]) + (o[2] * o[2] + o[3] * o[3]));
    const float mean = s1 * (1.f / 64.f); const float rs = __builtin_amdgcn_rsqf(fmaxf(s2 * (1.f / 64.f) - mean * mean, 0.f) + 64e-5f);
    const f32x4 y = (o - mean) * rs * *(const LAS f32x4*)(gg) + *(const LAS f32x4*)(gg + SC2_VEC);
    *(v2u*)(p.MIXIN + (size_t)(p.mb + (unsigned)(c * SC2_T) + (unsigned)p.tl) * (DM * 2) + p.offP) = pk4(y);
}
__device__ __forceinline__ void scan3_stager(KA A, LAS unsigned char* lds, int sw, int lane, int l, int b, int hd) {
    Sc2Par p;
    p.P = (const unsigned char*)(A->ws + WS_P); p.LO = (const unsigned char*)(A->ws + WS_LO); p.VF = (unsigned char*)((unsigned char*)A->out + OUT_VF); p.MIXIN = (unsigned char*)(A->ws + WS_MIXIN);
    const int st = lane >> 4; p.q4 = (lane & 15) * 4; const int cc = hd * 64 + p.q4; p.tl = 4 * sw + st; p.l = l;
    const float* mu = A->in[8] + (size_t)l * 3360;
    p.mu_r = *(const f32x4*)(mu + C_R + cc); p.mu_k = *(const f32x4*)(mu + C_K + cc); p.mu_v = *(const f32x4*)(mu + C_V + cc);
    p.w0c = *(const f32x4*)(A->in[10] + l * RW + cc); p.a0c = *(const f32x4*)(A->in[12] + l * RW + cc); p.kkc = *(const f32x4*)(A->in[15] + l * RW + cc); p.kac = *(const f32x4*)(A->in[16] + l * RW + cc);
    p.rkc = *(const f32x4*)(A->in[17] + l * RW + cc); p.gnw = *(const f32x4*)(A->in[18] + l * RW + cc); p.gnb = *(const f32x4*)(A->in[19] + l * RW + cc);
    p.v0c = l > 0 ? *(const f32x4*)(A->in[20] + (l - 1) * RW + cc) : (f32x4){0.f, 0.f, 0.f, 0.f};
    p.mb = (unsigned)b * SEQ; p.offP = (unsigned)cc * 2u;
    Sc2Raw R0, R1; Sc3Keep K;
    sc2_load(R0, p, 0); sc2_load(R1, p, 1);
    sc3_phaseA(R0, p, lds, 0, 0, K); sc2_load(R0, p, 2);
    __syncthreads();
    sc3_phaseB(K, p, lds, 0);
    sc3_phaseA(R1, p, lds, 1, 1, K); sc2_load(R1, p, 3);
    __syncthreads();
#ifdef PROBE_STG2
#define SC3_DUPB(ci) if ((ci) + 1 < SC2_NC) { asm volatile("" ::: "memory"); sc3_phaseB(K, p, lds, (ci) + 1); }
#define SC3_DUPA(ci, RN) if ((ci) + 2 < SC2_NC) { asm volatile("" : "+v"(RN.pr.x), "+v"(RN.pk.x), "+v"(RN.pv.x), "+v"(RN.ld.x), "+v"(RN.la.x), "+v"(RN.lg.x), "+v"(RN.pr.y), "+v"(RN.pk.y), "+v"(RN.pv.y), "+v"(RN.ld.y), "+v"(RN.la.y), "+v"(RN.lg.y) :: "memory"); sc3_phaseA(RN, p, lds, (ci) + 2, ((ci) + 2) & 3, K); }
#else
#define SC3_DUPB(ci)
#define SC3_DUPA(ci, RN)
#endif
#define SC3_BODY(ci, RN) do { if ((ci) < SC2_NC) { if ((ci) + 1 < SC2_NC) sc3_phaseB(K, p, lds, (ci) + 1); SC3_DUPB(ci) if ((ci) + 2 < SC2_NC) sc3_phaseA(RN, p, lds, (ci) + 2, ((ci) + 2) & 3, K); SC3_DUPA(ci, RN) \
        if ((ci) + 4 < SC2_NC) sc2_load(RN, p, (ci) + 4); __syncthreads(); } } while (0)
    for (int c = 0; c < SC2_NC; c += 2) { SC3_BODY(c, R0); SC3_BODY(c + 1, R1); }
#undef SC3_BODY
}
__device__ __forceinline__ void scan3_poster(KA A, LAS unsigned char* lds, int which, int lane, int b, int hd) {
    Sc2Par p; p.MIXIN = (unsigned char*)(A->ws + WS_MIXIN); p.q4 = (lane & 15) * 4; p.mb = (unsigned)b * SEQ; p.offP = (unsigned)(hd * 64 + p.q4) * 2u;
    const int t0 = 8 * which + (lane >> 4);
    __syncthreads(); __syncthreads();
    for (int ci = 0; ci < SC2_NC; ++ci) {
        if (ci >= 1) { p.tl = t0; sc3_post(p, lds, ci - 1, (ci - 1) & 3); p.tl = t0 + 4; sc3_post(p, lds, ci - 1, (ci - 1) & 3); }
        __syncthreads();
    }
    p.tl = t0; sc3_post(p, lds, SC2_NC - 1, (SC2_NC - 1) & 3); p.tl = t0 + 4; sc3_post(p, lds, SC2_NC - 1, (SC2_NC - 1) & 3);
}
__device__ __forceinline__ void scan3_idle() {
    __syncthreads(); __syncthreads();
    for (int c = 0; c < SC2_NC; ++c) __syncthreads();
}
__device__ __forceinline__ void scan3_core(LAS unsigned char* lds, int lane0) {
    f32x16 ZT[2][2];
#pragma unroll
    for (int J = 0; J < 2; ++J)
#pragma unroll
        for (int I = 0; I < 2; ++I) ZT[J][I] = (f32x16){0.f, 0.f, 0.f, 0.f, 0.f, 0.f, 0.f, 0.f, 0.f, 0.f, 0.f, 0.f, 0.f, 0.f, 0.f, 0.f};
    for (int k = lane0; k < 2560 / 16; k += 64) ((LAS v4u*)(lds + S3_OFF_GS))[k] = (v4u){0u, 0u, 0u, 0u};
    __syncthreads(); __syncthreads();
    for (int c = 0; c < SC2_NC; ++c) {
        int lane = lane0; asm volatile("" : "+v"(lane));
        const int r = lane & 31, h = lane >> 5;
        LAS unsigned char* const sb = lds + (c & 1) * S3_SET;
        const LAS unsigned char* const pA = sb + S3_AR + (r * 72 + 8 * h) * 2;
        const LAS unsigned char* const pB = sb + S3_BK + (r * 72 + 8 * h) * 2;
        LAS float* const pLM = (LAS float*)(lds + S3_OFF_LM) + 4 * h * 36 + r;
        LAS float* const pGS = (LAS float*)(lds + S3_OFF_GS) + 4 * h * 64 + r;
        const LAS float* const LMu = (const LAS float*)(lds + S3_OFF_LM);
        const LAS float* const pGl = (const LAS float*)(lds + S3_OFF_GS) + lane;
        LAS unsigned char* const pUV = sb + S3_UVT + lane * 80;
        LAS float* const pOut = (LAS float*)(lds + S3_OFF_OUT + (c & 1) * SC2_OUT_B) + lane;
        const LAS unsigned char* const pBT = sb + S3_BKT + (r * 40 + 8 * h) * 2;
        const LAS unsigned char* const pUT = sb + S3_UVT + (r * 40 + 8 * h) * 2;
        const LAS float* const pPC = (const LAS float*)(sb + S3_PC) + 4 * h;
        const int rp = (r < 16) ? ((r & ~12) | ((r & 4) << 1) | ((r & 8) >> 1)) : r;
        LAS unsigned char* const pLMBw = lds + S3_OFF_LMB + (4 * h * 40 + rp) * 2;
        const LAS unsigned char* const pLMBa = lds + S3_OFF_LMB + (r * 40 + 8 * h) * 2;
        LAS float* const pOutD = (LAS float*)(lds + S3_OFF_OUT + (c & 1) * SC2_OUT_B) + 4 * h * 64 + r;
        const int tc = lane & 15, tcp = (tc & ~12) | ((tc & 4) << 1) | ((tc & 8) >> 1);
        LAS unsigned char* const pTw = lds + S3_OFF_GS + tcp * 2;
        const LAS unsigned char* const pTa = lds + S3_OFF_GS + (r * 40 + 8 * h) * 2;
        f32x16 acc0, acc1;
        {
            bf16x8 af[4];
            f32x16 LM = (f32x16){0.f, 0.f, 0.f, 0.f, 0.f, 0.f, 0.f, 0.f, 0.f, 0.f, 0.f, 0.f, 0.f, 0.f, 0.f, 0.f}, G0 = LM, G1 = LM;
#pragma unroll
            for (int ks = 0; ks < 4; ++ks) { af[ks] = *(const LAS bf16x8*)(pA + ks * 32); LM = __builtin_amdgcn_mfma_f32_32x32x16_bf16(af[ks], *(const LAS bf16x8*)(pB + ks * 32), LM, 0, 0, 0); }
#pragma unroll
            for (int reg = 0; reg < 16; ++reg) { const int ro = (reg & 3) + 8 * (reg >> 2);
                if (reg < 8) pLM[ro * 36] = LM[reg];
                const int tq = (reg < 8 ? ro : ro - 16) + 4 * h;
                const bool keep = (reg < 8) ? (r >= 16 && (r - 16) < tq) : ((r & 15) <= tq);
                *(LAS bf16*)(pLMBw + ro * 80) = keep ? f2bf(LM[reg]) : (bf16)0; }
#pragma unroll
            for (int ks = 0; ks < 4; ++ks) {
                const int J = ks >> 1, o8 = 8 * (ks & 1);
                v4u z0, z1;
                z0.x = cvtpk(ZT[J][0][o8 + 0], ZT[J][0][o8 + 1]); z0.y = cvtpk(ZT[J][0][o8 + 2], ZT[J][0][o8 + 3]); z0.z = cvtpk(ZT[J][0][o8 + 4], ZT[J][0][o8 + 5]); z0.w = cvtpk(ZT[J][0][o8 + 6], ZT[J][0][o8 + 7]);
                z1.x = cvtpk(ZT[J][1][o8 + 0], ZT[J][1][o8 + 1]); z1.y = cvtpk(ZT[J][1][o8 + 2], ZT[J][1][o8 + 3]); z1.z = cvtpk(ZT[J][1][o8 + 4], ZT[J][1][o8 + 5]); z1.w = cvtpk(ZT[J][1][o8 + 6], ZT[J][1][o8 + 7]);
                G0 = __builtin_amdgcn_mfma_f32_32x32x16_bf16(af[ks], __builtin_bit_cast(bf16x8, z0), G0, 0, 0, 0);
                G1 = __builtin_amdgcn_mfma_f32_32x32x16_bf16(af[ks], __builtin_bit_cast(bf16x8, z1), G1, 0, 0, 0);
            }
            LDS_WAIT(); asm volatile("" ::: "memory");
            const bf16x8 a1 = *(const LAS bf16x8*)(pLMBa + 32);
            acc0 = __builtin_amdgcn_mfma_f32_32x32x16_bf16(a1, *(const LAS bf16x8*)(pUT + 32), G0, 0, 0, 0);
            acc1 = __builtin_amdgcn_mfma_f32_32x32x16_bf16(a1, *(const LAS bf16x8*)(pUT + 32 * 80 + 32), G1, 0, 0, 0);
        }
#ifdef PROBE_CORE2
#pragma unroll 1
        for (int rep = 0; rep < 2; ++rep)
#endif
        {
            float T[16];
#pragma unroll
            for (int t = 0; t < 16; ++t) {
                float acc = (tc == t) ? 1.f : 0.f;
#pragma unroll
                for (int s4 = 0; 4 * s4 < t; ++s4) { const f32x4 la = *(const LAS f32x4*)(LMu + t * 36 + 4 * s4);
#pragma unroll
                    for (int e = 0; e < 4; ++e) if (4 * s4 + e < t) asm("v_fma_f32 %0, -%1, %2, %0" : "+v"(acc) : "v"(la[e]), "v"(T[4 * s4 + e])); }
                T[t] = acc;
                *(LAS bf16*)(pTw + t * 80) = f2bf(acc);
                if ((t & 3) == 3) asm volatile("" ::: "memory");
            }
        }
        LDS_WAIT(); asm volatile("" ::: "memory");
        bf16x8 nu0, nu1;
        {
            const bf16x8 ta = *(const LAS bf16x8*)(pTa);
            const f32x16 zero16 = (f32x16){0.f, 0.f, 0.f, 0.f, 0.f, 0.f, 0.f, 0.f, 0.f, 0.f, 0.f, 0.f, 0.f, 0.f, 0.f, 0.f};
            v4u p0, p1;
            p0.x = cvtpk(acc0[0], acc0[1]); p0.y = cvtpk(acc0[2], acc0[3]); p0.z = cvtpk(acc0[4], acc0[5]); p0.w = cvtpk(acc0[6], acc0[7]);
            p1.x = cvtpk(acc1[0], acc1[1]); p1.y = cvtpk(acc1[2], acc1[3]); p1.z = cvtpk(acc1[4], acc1[5]); p1.w = cvtpk(acc1[6], acc1[7]);
            const f32x16 u0 = __builtin_amdgcn_mfma_f32_32x32x16_bf16(ta, __builtin_bit_cast(bf16x8, p0), zero16, 0, 0, 0);
            const f32x16 u1 = __builtin_amdgcn_mfma_f32_32x32x16_bf16(ta, __builtin_bit_cast(bf16x8, p1), zero16, 0, 0, 0);
            v4u q0, q1;
            q0.x = cvtpk(-u0[0], -u0[1]); q0.y = cvtpk(-u0[2], -u0[3]); q0.z = cvtpk(-u0[4], -u0[5]); q0.w = cvtpk(-u0[6], -u0[7]);
            q1.x = cvtpk(-u1[0], -u1[1]); q1.y = cvtpk(-u1[2], -u1[3]); q1.z = cvtpk(-u1[4], -u1[5]); q1.w = cvtpk(-u1[6], -u1[7]);
            nu0 = __builtin_bit_cast(bf16x8, q0); nu1 = __builtin_bit_cast(bf16x8, q1);
        }
        {
            const bf16x8 a2 = *(const LAS bf16x8*)(pLMBa);
            acc0 = __builtin_amdgcn_mfma_f32_32x32x16_bf16(a2, nu0, acc0, 0, 0, 0);
            acc1 = __builtin_amdgcn_mfma_f32_32x32x16_bf16(a2, nu1, acc1, 0, 0, 0);
#pragma unroll
            for (int reg = 8; reg < 16; ++reg) { const int ro = (reg & 3) + 8 * (reg >> 2) - 16; pOutD[ro * 64] = acc0[reg]; pOutD[ro * 64 + 32] = acc1[reg]; }
        }
        {
            bf16x8 abk[2][2], bv[2];
#pragma unroll
            for (int X = 0; X < 2; ++X) { bv[X] = *(const LAS bf16x8*)(pUT + X * 32 * 80 + 32);
#pragma unroll
                for (int ks = 0; ks < 2; ++ks) abk[X][ks] = *(const LAS bf16x8*)(pBT + X * 32 * 80 + ks * 32); }
#pragma unroll
            for (int J = 0; J < 2; ++J) {
                ZT[J][0] = __builtin_amdgcn_mfma_f32_32x32x16_bf16(abk[J][0], nu0, ZT[J][0], 0, 0, 0); ZT[J][1] = __builtin_amdgcn_mfma_f32_32x32x16_bf16(abk[J][0], nu1, ZT[J][1], 0, 0, 0);
                ZT[J][0] = __builtin_amdgcn_mfma_f32_32x32x16_bf16(abk[J][1], bv[0], ZT[J][0], 0, 0, 0); ZT[J][1] = __builtin_amdgcn_mfma_f32_32x32x16_bf16(abk[J][1], bv[1], ZT[J][1], 0, 0, 0); }
#pragma unroll
            for (int J = 0; J < 2; ++J)
#pragma unroll
                for (int g = 0; g < 4; ++g) { const f32x4 pc = *(const LAS f32x4*)(pPC + 32 * J + 8 * g);
#pragma unroll
                    for (int I = 0; I < 2; ++I) {
#pragma unroll
                        for (int e = 0; e < 4; ++e) ZT[J][I][4 * g + e] *= pc[e]; } }
        }
        LDS_WAIT(); asm volatile("" ::: "memory");
        __syncthreads();
    }
}
#ifndef STG4
#define STG4 5
#endif
__device__ __forceinline__ void ph_scan3(KA A, const Ctx& C, int l) {
    for (int bh = blockIdx.x; bh < BATCH * 16; bh += C.G) {
        const int w = C.wave;
        if (w == 0) scan3_core(C.lds, C.lane);
        else if (w == 1 || w == 2 || w == 3 || w == STG4) scan3_stager(A, C.lds, w == STG4 ? 3 : w - 1, C.lane, l, bh >> 4, bh & 15);
        else if (w == 6 || w == 7) scan3_poster(A, C.lds, w - 6, C.lane, bh >> 4, bh & 15);
        else scan3_idle();
        __syncthreads();
    }
}
__device__ __forceinline__ void ph_scan2(KA A, const Ctx& C, int l) {
    for (int bh = blockIdx.x; bh < BATCH * 16; bh += C.G) {
        if (C.wave < 4) scan2_scanner(C.lds, C.wave, C.lane);
        else scan2_stager(A, C.lds, C.wave - 4, C.lane, l, bh >> 4, bh & 15);
        __syncthreads();
    }
}
#ifdef SCAN_SEQUENTIAL
#define SCAN_IMPL ph_scan2
#else
#define SCAN_IMPL ph_scan3
#endif
#ifdef ATTN_TWO_PASS
#define ATT_IMPL ph_attn
#else
#define ATT_IMPL ph_attn2
#endif
__device__ __forceinline__ void ph_mixer(KA A, const Ctx& C, int l) {
#ifdef PROBE_ATTN_FIRST
    ATT_IMPL(A, C, l, (unsigned*)(A->ws + WS_CTL) + CW_Q + 64 * l);
    __syncthreads();
#ifdef PROBE_ATTN_REP
    ATT_IMPL(A, C, l, (unsigned*)(A->ws + WS_CTL) + CW_Q + 64 * l + 32);
    __syncthreads();
#endif
    SCAN_IMPL(A, C, l);
#else
    SCAN_IMPL(A, C, l);
#ifdef PROBE_SCAN_REP
    SCAN_IMPL(A, C, l);
#endif
    Ctx C2 = C; asm volatile("v_mbcnt_lo_u32_b32 %0, -1, 0\n\tv_mbcnt_hi_u32_b32 %0, -1, %0" : "=v"(C2.lane)); C2.tid = C2.wave * 64 + C2.lane;
    KA A2 = A; asm volatile("" : "+s"(A2));
    ATT_IMPL(A2, C2, l, (unsigned*)(A2->ws + WS_CTL) + CW_Q + 64 * l);
#endif
}
__global__ void __launch_bounds__(NWAVES * 64, 2) fwd_kernel(Args KARG) {
    extern __shared__ __attribute__((aligned(16))) unsigned char lds_raw[];
    Ctx C0;
    C0.lds = (LAS unsigned char*)lds_raw;
    C0.tid = 0; C0.lane = 0; C0.wave = __builtin_amdgcn_readfirstlane((int)threadIdx.x >> 6);
    C0.G = gridDim.x; { const int bx = blockIdx.x; C0.vcu = (C0.G % 8 == 0) ? (bx % 8) * (C0.G / 8) + bx / 8 : bx; }
    C0.gw = C0.vcu * NWAVES + C0.wave; C0.NGW = C0.G * NWAVES;
    for (int u = threadIdx.x; u < (LDS_BYTES - LDSCTL_OFF) / 4; u += NWAVES * 64) ((LAS unsigned*)(C0.lds + LDSCTL_OFF))[u] = 0u;
    __syncthreads();
    volatile LAS unsigned* MISC = (volatile LAS unsigned*)(C0.lds + MISC_OFF);
    unsigned* barw = (unsigned*)(KARG.ws + WS_CTL) + CW_BAR + KARG.li * XCD_BAR_WORDS;
    XcdBarrier bar; bar.bar = barw; bar.x = 0; bar.st = nullptr;
    const int lo = KARG.ph_lo, hi = KARG.ph_hi;
    if (hi - lo > 1) bar = xcd_barrier_post(barw, MISC + 8);
#ifdef NAIVE_ATTN
#define ATTN_CALL ph_attn_naive
#else
#define ATTN_CALL(A_, C_, l_) ph_attn(A_, C_, l_, (unsigned*)((A_)->ws + WS_CTL) + CW_Q + 64 * (l_))
#endif
#ifdef NAIVE_SCAN
#define SCAN_CALL ph_scan_naive
#else
#define SCAN_CALL ph_scan
#endif
#ifdef NAIVE_LORA
#define LORA_CALL ph_lora_naive(A, C, l);
#else
#define LORA_CALL pg8::Gemm g{(const bf16*)(ws + WS_LA), (const bf16*)(ws + WS_WL), M, LON, LAK}; pg8::StaticOrder S; S.init(M, LON, C.G, (int)blockIdx.x, 2, 4, 1); pg8::EpiBf16<0, true> E{(bf16*)(ws + WS_LO), LON, nullptr, 0, 0, 1.f};                  pg8::gemm_phase<pg8::EpiBf16<0, true>, pg8::StaticOrder, true, true>(C.lds, g, S, E, C.tid);
#endif
#if defined(NAIVE_ATTN) || defined(NAIVE_SCAN)
#define MIXER_CALL ATTN_CALL(A, C, l); __syncthreads(); SCAN_CALL(A, C, l);
#else
#define MIXER_CALL ph_mixer(A, C, l);
#endif
#ifndef WGM_IN
#define WGM_IN 4
#endif
#ifndef WGM_LORA
#define WGM_LORA 4
#endif
#ifndef WGM_UP
#define WGM_UP 4
#endif
#ifndef WGM_OUT
#define WGM_OUT 4
#endif
#ifndef WGM_DOWN
#define WGM_DOWN 4
#endif
#ifndef PH_REP
#define PH_REP 0
#endif
#ifndef PH_MASK
#define PH_MASK 0x7ff
#endif
#define PHASE(k, ...) do { constexpr int pid = l * 11 + (k); if constexpr (!((k) == 0 && l > 0)) if (pid >= lo && pid < hi) { Ctx C = C0; asm volatile("v_mbcnt_lo_u32_b32 %0, -1, 0\n\tv_mbcnt_hi_u32_b32 %0, -1, %0" : "=v"(C.lane)); C.tid = C.wave * 64 + C.lane; \
        if constexpr ((PH_MASK >> (k)) & 1) { KA A = (KA)__builtin_amdgcn_kernarg_segment_ptr(); asm volatile("" : "+s"(A)); unsigned char* ws = A->ws; bf16* H = (bf16*)((unsigned char*)A->out + OUT_H); bf16* XB = (bf16*)(ws + WS_XB); __VA_ARGS__; \
            if constexpr ((PH_REP >> (k)) & 1) { __syncthreads(); __VA_ARGS__; } } \
        if (pid + 1 < hi) xcd_barrier(bar, C.tid); } } while (0)
#define LAYER_BODY \
        PHASE(0, { ph_wconv(A, C, 0); ph_prologue(A, C); });        \
        PHASE(1, { pg8::Gemm g{H, (const bf16*)(ws + WS_WIN), M, PP, DM}; pg8::StaticOrder S; S.init(M, PP, C.G, (int)blockIdx.x, WGM_IN); pg8::EpiBf16<0, true> E{(bf16*)(ws + WS_P), PP, nullptr, 0, 0, 1.f}; \
                pg8::gemm_phase<pg8::EpiBf16<0, true>, pg8::StaticOrder, true, true>(C.lds, g, S, E, C.tid); }); \
        PHASE(2, { ph_e0(A, C, l); }); \
        PHASE(3, { LORA_CALL }); \
        PHASE(4, { MIXER_CALL }); \
        PHASE(5, { pg8::Gemm g{(const bf16*)(ws + WS_MIXIN), (const bf16*)(ws + WS_WOUT), M, DM, DM}; pg8::StaticOrder S; S.init(M, DM, C.G, (int)blockIdx.x, WGM_OUT); pg8::EpiBf16<0> E{(bf16*)(ws + WS_MIX), DM, nullptr, 0, 0, 1.f}; \
                pg8::gemm_phase<pg8::EpiBf16<0>, pg8::StaticOrder, true, true>(C.lds, g, S, E, C.tid); }); \
        PHASE(6, { ph_res(C, (const bf16*)(ws + WS_MIX), l == 0 ? A->in[0] : nullptr, XB, XB, nullptr, A->in[3] + (size_t)l * DM, A->in[4] + (size_t)l * DM, H); }); \
        PHASE(7, { pg8::Gemm g{H, (const bf16*)(ws + WS_WUP), M, 2 * DFF, DM}; pg8::StaticOrder S; S.init(M, 2 * DFF, C.G, (int)blockIdx.x, WGM_UP); \
                EpiAct E{(bf16*)(ws + WS_ACT), A->in[29] + (size_t)l * 3 * DFF, A->in[30] + (size_t)l * DFF, (bf16*)(ws + WS_GL), (bf16*)(ws + WS_R01), (LAS float*)(C.lds + BND_OFF)}; \
                pg8::gemm_phase<EpiAct, pg8::StaticOrder, true, true>(C.lds, g, S, E, C.tid); }); \
        PHASE(8, { ph_actfix(A, C, l); }); \
        PHASE(9, { pg8::Gemm g{(const bf16*)(ws + WS_ACT), (const bf16*)(ws + WS_WDN), M, DM, DFF}; pg8::StaticOrder S; S.init(M, DM, C.G, (int)blockIdx.x, WGM_DOWN); pg8::EpiBf16<0> E{(bf16*)(ws + WS_FF), DM, nullptr, 0, 0, 1.f}; \
                pg8::gemm_phase<pg8::EpiBf16<0>, pg8::StaticOrder, true, true>(C.lds, g, S, E, C.tid); }); \
        PHASE(10, { ph_res(C, (const bf16*)(ws + WS_FF), nullptr, XB, l + 1 < DEPTH ? XB : nullptr, l + 1 < DEPTH ? nullptr : A->out, A->in[5] + (size_t)l * DM, l + 1 < DEPTH ? A->in[2] + (size_t)(l + 1) * DM : nullptr, H); if constexpr (l + 1 < DEPTH) ph_wconv(A, C, l + 1); }); \

    { constexpr int l = 0; LAYER_BODY }
    { constexpr int l = 1; LAYER_BODY }
    { constexpr int l = 2; LAYER_BODY }
    { constexpr int l = 3; LAYER_BODY }
#undef LAYER_BODY
#undef PHASE
}

extern "C" void kernel_launch(void* const* d_in, const int* in_sizes, int n_in, void* d_out, int out_size, void* d_ws, size_t ws_size, hipStream_t stream) {
    static int grid = 0;
    if (grid == 0) {
        if (n_in != 32 || in_sizes[0] != M * DM || out_size != M * DM || ws_size < WS_END) { fprintf(stderr, "kernel_launch: unexpected problem (n_in %d, out %d, ws %zu < %zu)\n", n_in, out_size, ws_size, (size_t)WS_END); grid = -1; return; }
        int dev = 0, cus = 0, per_cu = 0;
        if (hipGetDevice(&dev) != hipSuccess || hipDeviceGetAttribute(&cus, hipDeviceAttributeMultiprocessorCount, dev) != hipSuccess) { grid = -1; return; }
        if (hipFuncSetAttribute((const void*)fwd_kernel, hipFuncAttributeMaxDynamicSharedMemorySize, LDS_BYTES) != hipSuccess) { fprintf(stderr, "kernel_launch: hipFuncSetAttribute failed\n"); grid = -1; return; }
        if (hipOccupancyMaxActiveBlocksPerMultiprocessor(&per_cu, (const void*)fwd_kernel, NWAVES * 64, LDS_BYTES) != hipSuccess || per_cu < 1) fprintf(stderr, "kernel_launch: occupancy query reports %d\n", per_cu);
        (void)hipGetLastError();
        grid = cus;
    }
    if (grid < 0) return;
    if (hipMemsetAsync((char*)d_ws + WS_CTL, 0, CTL_ZERO_BYTES, stream) != hipSuccess) return;
    Args a{};
    for (int i = 0; i < 32; ++i) a.in[i] = (const float*)d_in[i];
    a.out = (float*)d_out; a.ws = (unsigned char*)d_ws;
#if MK_SINGLE
    a.ph_lo = 0; a.ph_hi = NPHASE; a.li = 0;
    hipLaunchKernelGGL(fwd_kernel, dim3(grid), dim3(NWAVES * 64), LDS_BYTES, stream, a);
#else
    for (int p = 0; p < NPHASE; ++p) { a.ph_lo = p; a.ph_hi = p + 1; a.li = 0; hipLaunchKernelGGL(fwd_kernel, dim3(grid), dim3(NWAVES * 64), LDS_BYTES, stream, a); }
#endif
}
```
